# Optimizing an MI355X kernel written in HIP

```python
import math
import jax
import jax.numpy as jnp
from jax import lax
import numpy as np

D_MODEL = 1024
BATCH = 8
SEQ = 4096
DEPTH = 4

GRID_W = 64
CTX_LEN = 256
D_MIX = D_MODEL
D_S5 = D_MIX // 2
S5_GROUP = 16
S5_GROUPS = D_S5 // S5_GROUP
S5_STATE = 64
D_LRU = D_MIX - D_S5
LRU_HEADS = 8
LRU_HEAD_DIM = D_LRU // LRU_HEADS
CONV_W = 4
CONV_LEFT = CONV_W // 2
LRU_C = 8.0
D_IN = D_S5 + 2 * D_LRU
D_FF = -(-(8 * D_MODEL) // (3 * 256)) * 256
N_DIR = 2
EPS = 1e-6

kernel_name = "hybrid_s5_rglru_dit_block"


def rms_norm(x, g):
    xf = x.astype(jnp.float32)
    var = jnp.mean(xf * xf, axis=-1, keepdims=True)
    return (xf * lax.rsqrt(var + EPS)).astype(x.dtype) * g


def adaln(cond, w, b):
    m = (jax.nn.silu(cond) @ w + b)[..., None, :]
    return jnp.split(m, 6, axis=-1)


def to_col_major(t, rows):
    b, l, ch = t.shape
    return t.reshape(b, rows, GRID_W, ch).transpose(0, 2, 1, 3).reshape(b, l, ch)


def from_col_major(t, rows):
    b, l, ch = t.shape
    return t.reshape(b, GRID_W, rows, ch).transpose(0, 2, 1, 3).reshape(b, l, ch)


def _real_combine(left, right):
    a1, b1 = left
    a2, b2 = right
    return a1 * a2, a2 * b1 + b2


def _cplx_combine(left, right):
    ar1, ai1, br1, bi1 = left
    ar2, ai2, br2, bi2 = right
    return (ar2 * ar1 - ai2 * ai1,
            ar2 * ai1 + ai2 * ar1,
            ar2 * br1 - ai2 * bi1 + br2,
            ar2 * bi1 + ai2 * br1 + bi2)


def linear_scan(a, b, h0, reverse):
    if h0 is not None:
        edge = -1 if reverse else 0
        b = b.at[:, edge].add(a[:, edge] * h0)
    _, h = lax.associative_scan(_real_combine, (a, b), axis=1, reverse=reverse)
    return h


def s5_discretise(a_re, a_im, log_dt, b_re, b_im):
    dt = jnp.exp(log_dt)[:, None]
    mag = jnp.exp(a_re * dt)
    ab_re = mag * jnp.cos(a_im * dt)
    ab_im = mag * jnp.sin(a_im * dt)
    den = a_re * a_re + a_im * a_im
    nr = ab_re - 1.0
    f_re = (nr * a_re + ab_im * a_im) / den
    f_im = (ab_im * a_re - nr * a_im) / den
    bb_re = f_re[..., None] * b_re - f_im[..., None] * b_im
    bb_im = f_re[..., None] * b_im + f_im[..., None] * b_re
    return ab_re, ab_im, bb_re, bb_im


def s5_scan(u, disc, s0, reverse):
    ab_re, ab_im, bb_re, bb_im = disc
    b, l, _ = u.shape
    ug = u.reshape(b, l, S5_GROUPS, S5_GROUP)
    x_re = jnp.einsum('blgp,gnp->blgn', ug, bb_re)
    x_im = jnp.einsum('blgp,gnp->blgn', ug, bb_im)
    if s0 is not None:
        edge = -1 if reverse else 0
        s0_re, s0_im = s0
        x_re = x_re.at[:, edge].add(ab_re * s0_re - ab_im * s0_im)
        x_im = x_im.at[:, edge].add(ab_re * s0_im + ab_im * s0_re)
    a_re = jnp.broadcast_to(ab_re, (1, l) + ab_re.shape)
    a_im = jnp.broadcast_to(ab_im, (1, l) + ab_im.shape)
    _, _, s_re, s_im = lax.associative_scan(_cplx_combine, (a_re, a_im, x_re, x_im), axis=1, reverse=reverse)
    return s_re, s_im


def s5_readout(s_re, s_im, c_re, c_im):
    y = jnp.einsum('blgn,gpn->blgp', s_re, c_re) - jnp.einsum('blgn,gpn->blgp', s_im, c_im)
    b, l = y.shape[:2]
    return y.reshape(b, l, D_S5)


def s5_glu(y, w_glu, b_glu):
    y = jax.nn.gelu(y)
    return y * jax.nn.sigmoid(y @ w_glu + b_glu)


def centred_depthwise_conv(x, w, b):
    l = x.shape[1]
    xp = jnp.pad(x, ((0, 0), (CONV_LEFT, CONV_W - 1 - CONV_LEFT), (0, 0)))
    out = xp[:, 0:l] * w[0]
    for k in range(1, CONV_W):
        out = out + xp[:, k:k + l] * w[k]
    return out + b


def block_diag(x, w, b):
    xh = x.reshape(x.shape[:-1] + (LRU_HEADS, LRU_HEAD_DIM))
    return jnp.einsum('blhi,hij->blhj', xh, w).reshape(x.shape) + b


def rglru_coeffs(x, w_rg, b_rg, w_ig, b_ig, lam):
    r = jax.nn.sigmoid(block_diag(x, w_rg, b_rg))
    i = jax.nn.sigmoid(block_diag(x, w_ig, b_ig))
    log_a = -LRU_C * r * jax.nn.softplus(-lam)
    a = jnp.exp(log_a)
    mult = jnp.sqrt(-jnp.expm1(2.0 * log_a))
    return a, mult * (i * x)


def hybrid_mixer(h_lat, h_ctx, rows, need_ctx, w_in,
                 s5_a_re, s5_a_im, s5_log_dt, s5_b_re, s5_b_im, s5_c_re, s5_c_im, s5_d, s5_w_glu, s5_b_glu,
                 lru_conv_w, lru_conv_b, lru_w_rg, lru_b_rg, lru_w_ig, lru_b_ig, lru_lambda, w_out):
    split = [D_S5, D_S5 + D_LRU]
    u_lat, xr_lat, gr_lat = jnp.split(h_lat @ w_in, split, axis=-1)
    u_ctx, xr_ctx, gr_ctx = jnp.split(h_ctx @ w_in, split, axis=-1)

    ys_lat, ys_ctx = [s5_d * u_lat], [s5_d * u_ctx]
    for d, reverse in enumerate((False, True)):
        disc = s5_discretise(s5_a_re[d], s5_a_im[d], s5_log_dt[d], s5_b_re[d], s5_b_im[d])
        edge = 0 if reverse else -1
        sc_re, sc_im = s5_scan(u_ctx, disc, None, reverse)
        sl_re, sl_im = s5_scan(u_lat, disc, (sc_re[:, edge], sc_im[:, edge]), reverse)
        ys_lat.append(s5_readout(sl_re, sl_im, s5_c_re[d], s5_c_im[d]))
        if need_ctx:
            ys_ctx.append(s5_readout(sc_re, sc_im, s5_c_re[d], s5_c_im[d]))
    y_s5_lat = s5_glu(ys_lat[0] + ys_lat[1] + ys_lat[2], s5_w_glu, s5_b_glu)

    xc_lat = centred_depthwise_conv(to_col_major(xr_lat, rows), lru_conv_w, lru_conv_b)
    xc_ctx = centred_depthwise_conv(xr_ctx, lru_conv_w, lru_conv_b)
    hs_lat, hs_ctx = [], []
    for d, reverse in enumerate((False, True)):
        edge = 0 if reverse else -1
        a_c, b_c = rglru_coeffs(xc_ctx, lru_w_rg[d], lru_b_rg[d], lru_w_ig[d], lru_b_ig[d], lru_lambda[d])
        h_c = linear_scan(a_c, b_c, None, reverse)
        a_l, b_l = rglru_coeffs(xc_lat, lru_w_rg[d], lru_b_rg[d], lru_w_ig[d], lru_b_ig[d], lru_lambda[d])
        hs_lat.append(linear_scan(a_l, b_l, h_c[:, edge], reverse))
        hs_ctx.append(h_c)
    y_lru_lat = from_col_major(hs_lat[0] + hs_lat[1], rows) * jax.nn.gelu(gr_lat)
    out_lat = jnp.concatenate([y_s5_lat, y_lru_lat], axis=-1) @ w_out

    out_ctx = None
    if need_ctx:
        y_s5_ctx = s5_glu(ys_ctx[0] + ys_ctx[1] + ys_ctx[2], s5_w_glu, s5_b_glu)
        y_lru_ctx = (hs_ctx[0] + hs_ctx[1]) * jax.nn.gelu(gr_ctx)
        out_ctx = jnp.concatenate([y_s5_ctx, y_lru_ctx], axis=-1) @ w_out
    return out_lat, out_ctx


def swiglu(h, w_ffn_in, w_ffn_out):
    gate, up = jnp.split(h @ w_ffn_in, 2, axis=-1)
    return (jax.nn.silu(gate) * up) @ w_ffn_out


def setup_inputs(seed: int = 0) -> dict:
    key = jax.random.key(seed)
    ks = jax.random.split(key, 32)
    f32 = jnp.float32

    def nrm(k, shape, scale):
        return scale * jax.random.normal(k, shape, f32)

    L, G, N, P = DEPTH, S5_GROUPS, S5_STATE, S5_GROUP
    n_idx = jnp.arange(N, dtype=f32)
    a_pow_c = jax.random.uniform(ks[24], (L, N_DIR, D_LRU), f32, 0.9, 0.999)
    a0 = a_pow_c ** (1.0 / LRU_C)
    return {
        "x": nrm(ks[0], (BATCH, SEQ, D_MODEL), 1.0),
        "c": nrm(ks[1], (BATCH, D_MODEL), 1.0),
        "ctx": nrm(ks[2], (BATCH, CTX_LEN, D_MODEL), 1.0),
        "c_ctx": nrm(ks[3], (D_MODEL,), 1.0),
        "w_ada": nrm(ks[4], (L, D_MODEL, 6 * D_MODEL), D_MODEL ** -0.5),
        "b_ada": nrm(ks[5], (L, 6 * D_MODEL), 0.02),
        "norm_gains": 1.0 + nrm(ks[6], (L, 4, D_MODEL), 0.05),
        "w_in": nrm(ks[7], (L, D_MODEL, D_IN), D_MODEL ** -0.5),
        "s5_a_re": -0.5 + nrm(ks[8], (L, N_DIR, G, N), 0.01),
        "s5_a_im": math.pi * n_idx + nrm(ks[9], (L, N_DIR, G, N), 0.01),
        "s5_log_dt": jax.random.uniform(ks[10], (L, N_DIR, G), f32, math.log(1e-3), math.log(1e-1)),
        "s5_b_re": nrm(ks[11], (L, N_DIR, G, N, P), (2 * P) ** -0.5),
        "s5_b_im": nrm(ks[12], (L, N_DIR, G, N, P), (2 * P) ** -0.5),
        "s5_c_re": nrm(ks[13], (L, N_DIR, G, P, N), (2 * N) ** -0.5),
        "s5_c_im": nrm(ks[14], (L, N_DIR, G, P, N), (2 * N) ** -0.5),
        "s5_d": nrm(ks[15], (L, D_S5), 1.0),
        "s5_w_glu": nrm(ks[16], (L, D_S5, D_S5), D_S5 ** -0.5),
        "s5_b_glu": nrm(ks[17], (L, D_S5), 0.01),
        "lru_conv_w": nrm(ks[18], (L, CONV_W, D_LRU), CONV_W ** -0.5),
        "lru_conv_b": nrm(ks[19], (L, D_LRU), 0.01),
        "lru_w_rg": nrm(ks[20], (L, N_DIR, LRU_HEADS, LRU_HEAD_DIM, LRU_HEAD_DIM), LRU_HEAD_DIM ** -0.5),
        "lru_b_rg": nrm(ks[21], (L, N_DIR, D_LRU), 0.01),
        "lru_w_ig": nrm(ks[22], (L, N_DIR, LRU_HEADS, LRU_HEAD_DIM, LRU_HEAD_DIM), LRU_HEAD_DIM ** -0.5),
        "lru_b_ig": nrm(ks[23], (L, N_DIR, D_LRU), 0.01),
        "lru_lambda": jnp.log(a0) - jnp.log1p(-a0),
        "w_out": nrm(ks[25], (L, D_MIX, D_MODEL), D_MIX ** -0.5),
        "w_ffn_in": nrm(ks[26], (L, D_MODEL, 2 * D_FF), D_MODEL ** -0.5),
        "w_ffn_out": nrm(ks[27], (L, D_FF, D_MODEL), D_FF ** -0.5),
    }


def reference(x, c, ctx, c_ctx, w_ada, b_ada, norm_gains, w_in,
              s5_a_re, s5_a_im, s5_log_dt, s5_b_re, s5_b_im, s5_c_re, s5_c_im, s5_d, s5_w_glu, s5_b_glu,
              lru_conv_w, lru_conv_b, lru_w_rg, lru_b_rg, lru_w_ig, lru_b_ig, lru_lambda,
              w_out, w_ffn_in, w_ffn_out):
    rows = x.shape[1] // GRID_W
    for layer in range(DEPTH):
        need_ctx = layer < DEPTH - 1
        g_pre_mix, g_post_mix, g_pre_ffn, g_post_ffn = norm_gains[layer]
        sh1, sc1, gt1, sh2, sc2, gt2 = adaln(c, w_ada[layer], b_ada[layer])
        csh1, csc1, cgt1, csh2, csc2, cgt2 = adaln(c_ctx, w_ada[layer], b_ada[layer])

        h_lat = rms_norm(x, g_pre_mix) * (1.0 + sc1) + sh1
        h_ctx = rms_norm(ctx, g_pre_mix) * (1.0 + csc1) + csh1
        out_lat, out_ctx = hybrid_mixer(
            h_lat, h_ctx, rows, need_ctx, w_in[layer],
            s5_a_re[layer], s5_a_im[layer], s5_log_dt[layer], s5_b_re[layer], s5_b_im[layer],
            s5_c_re[layer], s5_c_im[layer], s5_d[layer], s5_w_glu[layer], s5_b_glu[layer],
            lru_conv_w[layer], lru_conv_b[layer], lru_w_rg[layer], lru_b_rg[layer],
            lru_w_ig[layer], lru_b_ig[layer], lru_lambda[layer], w_out[layer])
        x = x + gt1 * rms_norm(out_lat, g_post_mix)

        f_lat = swiglu(rms_norm(x, g_pre_ffn) * (1.0 + sc2) + sh2, w_ffn_in[layer], w_ffn_out[layer])
        x = x + gt2 * rms_norm(f_lat, g_post_ffn)

        if need_ctx:
            ctx = ctx + cgt1 * rms_norm(out_ctx, g_post_mix)
            f_ctx = swiglu(rms_norm(ctx, g_pre_ffn) * (1.0 + csc2) + csh2, w_ffn_in[layer], w_ffn_out[layer])
            ctx = ctx + cgt2 * rms_norm(f_ctx, g_post_ffn)
    return x
```

```cpp
#include <hip/hip_runtime.h>
#include <hip/hip_cooperative_groups.h>
#include <cstdio>
namespace cg = cooperative_groups;

#define LAS __attribute__((address_space(3)))
#ifndef PM
#define PM 65535
#endif
typedef unsigned short bf16_t;
typedef short bf16x8 __attribute__((ext_vector_type(8)));
typedef float f32x4 __attribute__((ext_vector_type(4)));
typedef unsigned u32x4 __attribute__((ext_vector_type(4)));
typedef float f32x2 __attribute__((ext_vector_type(2)));

constexpr int D = 1024, NB = 8, SEQ = 4096, DEPTH = 4, CTXL = 256, POS = CTXL + SEQ, MTOK = NB * POS;
constexpr int DS5 = 512, NG = 32, DLRU = 512, NH = 8, DIN = 1536, DFF = 2816;
constexpr int TS = 32, SCH = POS / TS, MS = NB * SCH, MSP = 1280, K3 = 768, K1 = 512;
constexpr int LCH = 68;
constexpr float EPS = 1e-6f;
constexpr int LDS_BYTES = 147456;

constexpr size_t WS_CTXR = 0;
constexpr size_t WS_MOD = WS_CTXR + (size_t)NB * CTXL * D * 4;
constexpr size_t WS_WL = WS_MOD + 4 * 9 * 6144 * 4;
constexpr size_t WL_IN = 0, WL_GLU = WL_IN + 3145728, WL_OUT = WL_GLU + 524288, WL_FI = WL_OUT + 2097152, WL_FO = WL_FI + 11534336, WL_LRU = WL_FO + 5767168, WL_SIZE = WL_LRU + 262144;
constexpr size_t WS_BT3 = WS_WL + 4 * WL_SIZE;
constexpr size_t WS_BT1 = WS_BT3 + 25165824;
constexpr size_t WS_AT = WS_BT1 + 8388608;
constexpr size_t WS_BIG = WS_AT + 32768;
constexpr size_t WS_US5 = WS_BIG;
constexpr size_t WS_XG = WS_US5 + 62914560;
constexpr size_t WS_HLOC = WS_XG + 71303168;
constexpr size_t WS_Y1 = WS_HLOC + 35651584;
constexpr size_t BIG_SIZE = 205520896;
constexpr size_t WS_AFF = WS_BIG;
constexpr size_t WS_R2 = WS_BIG + BIG_SIZE;
constexpr size_t WS_R3 = WS_R2 + 71303168;
constexpr size_t WS_ROWSS = WS_R3 + 71303168;
constexpr size_t WS_LAGG = WS_ROWSS + 2228224;
constexpr size_t WS_LHIN = WS_LAGG + 4456448;
constexpr size_t WS_END = WS_LHIN + 2228224;

struct Args { const float* in[28]; float* out; unsigned char* ws; };
typedef const Args __attribute__((address_space(4)))* KArgP;
__device__ __forceinline__ KArgP kargs() { KArgP p = (KArgP)__builtin_amdgcn_kernarg_segment_ptr(); asm volatile("" : "+s"(p)); return p; }
__device__ __forceinline__ int fresh_tid() { int t = threadIdx.x; asm volatile("" : "+v"(t)); return t; }
__device__ __forceinline__ int fresh_bid() { int t = blockIdx.x; asm volatile("" : "+s"(t)); return t; }
__device__ __forceinline__ unsigned char* fresh_ws() { unsigned char* w = kargs()->ws; asm volatile("" : "+s"(w)); return w; }

__device__ __forceinline__ f32x2 mk2(float x, float y) { f32x2 r; r.x = x; r.y = y; return r; }
__device__ __forceinline__ unsigned cvt_pk_bf16(float lo, float hi) { unsigned r; asm("v_cvt_pk_bf16_f32 %0, %1, %2" : "=v"(r) : "v"(lo), "v"(hi)); return r; }
__device__ __forceinline__ float bf_lo(unsigned w) { return __uint_as_float(w << 16); }
__device__ __forceinline__ float bf_hi(unsigned w) { return __uint_as_float(w & 0xffff0000u); }
__device__ __forceinline__ float sigmoidf_(float x) { return __frcp_rn(1.0f + __expf(-x)); }
__device__ __forceinline__ float gelu_tanh(float x) { const float u = 1.5957691216057308f * (x + 0.044715f * x * x * x); return x * __frcp_rn(1.0f + __expf(-u)); }
__device__ __forceinline__ float siluf_(float x) { return x * __frcp_rn(1.0f + __expf(-x)); }

constexpr int BM = 256, BK = 64, HALF = 128, HTB = HALF * BK * 2, NXCD = 8, WGM = 8;
__device__ __forceinline__ int lds_byte(int r, int c) { const int st = (r >> 4) * 2 + (c >> 5), rr = r & 15, cc = c & 31, ob = rr * 64 + cc * 2; return st * 1024 + (ob ^ (((ob >> 9) & 1) << 5)); }
__device__ __forceinline__ void stage_rc(int b, int& R, int& C) { const int st = b / 1024, sb = b % 1024, swz = sb ^ (((sb >> 9) & 1) << 5); R = (st >> 1) * 16 + swz / 64; C = (st & 1) * 32 + (swz % 64) / 2; }
__device__ __forceinline__ int perm32(int rho) { const int n = rho >> 4, i = rho & 15; return 8 * (i >> 2) + 4 * n + (i & 3); }

struct Unit { const char* A; const char* B; int pm, pn, g; };

struct PlainOrder {
    const char* A; const char* B; size_t tA, tB; int nM, nN, nwg, G, c;
    __device__ void init(const void* A_, int lda, const void* B_, int ldb, int M, int N, int G_, int c_) {
        A = (const char*)A_; B = (const char*)B_; tA = (size_t)BM * lda * 2; tB = (size_t)BM * ldb * 2; nM = M / BM; nN = N / BM; nwg = nM * nN; G = G_; c = c_; }
    __device__ __forceinline__ bool next(int i, Unit& u) const {
        const long L = (long)i * G + c; if (L >= nwg) return false;
        int wgid = (int)L; { const int q = nwg / NXCD, r = nwg % NXCD, xcd = wgid % NXCD, off = wgid / NXCD; wgid = (xcd < r ? xcd * (q + 1) : r * (q + 1) + (xcd - r) * q) + off; }
        const int nig = WGM * nN, gid = wgid / nig, fm = gid * WGM, gsz = (nM - fm) < WGM ? (nM - fm) : WGM;
        u.pm = fm + ((wgid % nig) % gsz); u.pn = (wgid % nig) / gsz; u.g = 0;
        u.A = A + (size_t)u.pm * tA; u.B = B + (size_t)u.pn * tB; return true;
    }
};
struct BatchOrder {
    const char* A; const char* B; size_t tA, tB, gA, gB; int nM, nN, total, G, c;
    __device__ void init(const void* A_, int lda, size_t gA_, const void* B_, int ldb, size_t gB_, int nM_, int nN_, int ng, int G_, int c_) {
        A = (const char*)A_; B = (const char*)B_; tA = (size_t)BM * lda * 2; tB = (size_t)BM * ldb * 2; gA = gA_; gB = gB_; nM = nM_; nN = nN_; total = nM_ * nN_ * ng; G = G_; c = c_; }
    __device__ __forceinline__ bool next(int i, Unit& u) const {
        const long L = (long)i * G + c; if (L >= total) return false;
        const int per = nM * nN, g = (int)L / per, r = (int)L % per; u.g = g; u.pn = r / nM; u.pm = r % nM;
        u.A = A + (size_t)g * gA + (size_t)u.pm * tA; u.B = B + (size_t)g * gB + (size_t)u.pn * tB; return true;
    }
};

template <class Epi, class Sched>
__device__ __forceinline__ void gemm_phase(LAS unsigned char* lds, const int lda, const int ldb, const int K, const Sched& S, const Epi& E) {
    int tid_ = threadIdx.x; asm volatile("" : "+v"(tid_));
    const int tid = tid_, wid = __builtin_amdgcn_readfirstlane(tid >> 6), lane = tid & 63, wr = wid >> 2, wc = wid & 3, fr = lane & 15, fq = lane >> 4;
    const int nt = K / BK;
    unsigned voffA[2], voffB[2];
#pragma unroll
    for (int i = 0; i < 2; ++i) { int R, C; stage_rc(tid * 16 + i * 8192, R, C); const int Rb = Epi::PERM ? ((R & ~31) + perm32(R & 31)) : R;
        voffA[i] = (unsigned)(R * lda + C) * 2u; voffB[i] = (unsigned)(Rb * ldb + C) * 2u; }
    const size_t kstep = (size_t)(BK * 2);
    const size_t hstepA = (size_t)HALF * lda * 2, hstepB = (size_t)HALF * ldb * 2;
    const unsigned ldsw = (unsigned)wid * 1024u;
    const int aoff = lds_byte(wr * 64 + fr, fq * 8), boff = lds_byte(wc * 32 + fr, fq * 8);
#define PG8_SA(b, h) (((b) * 2 + (h)) * HTB)
#define PG8_SB(b, h) ((4 + (b) * 2 + (h)) * HTB)
#define PG8_STAGE(bufoff, gbase, voff) do { _Pragma("unroll") for (int _i = 0; _i < 2; ++_i) \
        __builtin_amdgcn_global_load_lds((const unsigned*)((const char*)(gbase) + (voff)[_i]), (LAS unsigned*)(lds + (bufoff) + ldsw + _i * 8192), 16, 0, 0); } while (0)
#define PG8_LDA(dst, b, h) do { _Pragma("unroll") for (int m = 0; m < 4; ++m) _Pragma("unroll") for (int k = 0; k < 2; ++k) dst[m][k] = *(const LAS bf16x8*)(lds + PG8_SA(b, h) + aoff + m * 2048 + k * 1024); } while (0)
#define PG8_LDB(dst, b, h) do { _Pragma("unroll") for (int n = 0; n < 2; ++n) _Pragma("unroll") for (int k = 0; k < 2; ++k) dst[n][k] = *(const LAS bf16x8*)(lds + PG8_SB(b, h) + boff + n * 2048 + k * 1024); } while (0)
#define PG8_MMA(ai, bj, At, Bt) do { __builtin_amdgcn_s_setprio(1); _Pragma("unroll") for (int m = 0; m < 4; ++m) _Pragma("unroll") for (int n = 0; n < 2; ++n) _Pragma("unroll") for (int k = 0; k < 2; ++k) \
        acc[ai][bj][m][n] = __builtin_amdgcn_mfma_f32_16x16x32_bf16(Bt[n][k], At[m][k], acc[ai][bj][m][n], 0, 0, 0); __builtin_amdgcn_s_setprio(0); } while (0)
#define PG8_WAIT_V(n) asm volatile("s_waitcnt vmcnt(" #n ")" ::: "memory")
#define PG8_WAIT_L(n) asm volatile("s_waitcnt lgkmcnt(" #n ")" ::: "memory")
#define PG8_BAR __builtin_amdgcn_s_barrier()
#define PG8_SCHED __builtin_amdgcn_sched_barrier(0)
    Unit cur, nxt; int ui = 0;
    if (!S.next(0, cur)) return;
    f32x4 acc[2][2][4][2];
#pragma unroll
    for (int a = 0; a < 2; ++a)
#pragma unroll
        for (int b = 0; b < 2; ++b)
#pragma unroll
            for (int m = 0; m < 4; ++m)
#pragma unroll
                for (int n = 0; n < 2; ++n) acc[a][b][m][n] = (f32x4){0.f, 0.f, 0.f, 0.f};
    bf16x8 At[4][2], B0[2][2], B1[2][2];
    const char* cA = cur.A; const char* cB = cur.B;
    PG8_STAGE(PG8_SB(0, 0), cB, voffB); PG8_STAGE(PG8_SA(0, 0), cA, voffA); PG8_STAGE(PG8_SB(0, 1), cB + hstepB, voffB); PG8_STAGE(PG8_SA(0, 1), cA + hstepA, voffA);
    if (wr == 1) PG8_BAR;
    PG8_WAIT_V(4); PG8_BAR;
    PG8_STAGE(PG8_SB(1, 0), cB + kstep, voffB); PG8_STAGE(PG8_SA(1, 0), cA + kstep, voffA); PG8_STAGE(PG8_SB(1, 1), cB + hstepB + kstep, voffB);
    PG8_WAIT_V(6); PG8_BAR;
    for (;;) {
        const bool has_next = S.next(ui + 1, nxt);
        const char* nA = has_next ? nxt.A : cA; const char* nB = has_next ? nxt.B : cB;
        for (int t = 0; t < nt; t += 2) {
            const bool last = (t == nt - 2);
            const char* a1 = cA + (size_t)(t + 1) * kstep;
            const char* a2 = last ? nA : cA + (size_t)(t + 2) * kstep; const char* b2 = last ? nB : cB + (size_t)(t + 2) * kstep;
            const char* a3 = a2 + kstep; const char* b3 = b2 + kstep;
            PG8_LDB(B0, 0, 0); PG8_SCHED; PG8_LDA(At, 0, 0); PG8_STAGE(PG8_SA(1, 1), a1 + hstepA, voffA);
            PG8_WAIT_L(8); PG8_BAR; PG8_WAIT_L(0); PG8_MMA(0, 0, At, B0); PG8_BAR; PG8_SCHED;
            PG8_LDB(B1, 0, 1); PG8_STAGE(PG8_SB(0, 0), b2, voffB);
            PG8_BAR; PG8_WAIT_L(0); PG8_MMA(0, 1, At, B1); PG8_BAR;
            PG8_LDA(At, 0, 1); PG8_STAGE(PG8_SA(0, 0), a2, voffA);
            PG8_BAR; PG8_WAIT_L(0); PG8_MMA(1, 0, At, B0); PG8_BAR; PG8_SCHED;
            PG8_STAGE(PG8_SB(0, 1), b2 + hstepB, voffB);
            PG8_WAIT_V(6); PG8_BAR; PG8_MMA(1, 1, At, B1); PG8_BAR;
            PG8_LDB(B0, 1, 0); PG8_SCHED; PG8_LDA(At, 1, 0); PG8_STAGE(PG8_SA(0, 1), a2 + hstepA, voffA);
            PG8_WAIT_L(8); PG8_BAR; PG8_WAIT_L(0); PG8_MMA(0, 0, At, B0); PG8_BAR; PG8_SCHED;
            PG8_LDB(B1, 1, 1); PG8_STAGE(PG8_SB(1, 0), b3, voffB);
            PG8_BAR; PG8_WAIT_L(0); PG8_MMA(0, 1, At, B1); PG8_BAR;
            PG8_LDA(At, 1, 1); PG8_STAGE(PG8_SA(1, 0), a3, voffA);
            PG8_BAR; PG8_WAIT_L(0); PG8_MMA(1, 0, At, B0); PG8_BAR; PG8_SCHED;
            PG8_STAGE(PG8_SB(1, 1), b3 + hstepB, voffB);
            PG8_WAIT_V(6); PG8_BAR; PG8_MMA(1, 1, At, B1); PG8_BAR;
        }
        E(acc, cur, wr, wc, fr, fq);
        if (!has_next) break;
#pragma unroll
        for (int a = 0; a < 2; ++a)
#pragma unroll
            for (int b = 0; b < 2; ++b)
#pragma unroll
                for (int m = 0; m < 4; ++m)
#pragma unroll
                    for (int n = 0; n < 2; ++n) acc[a][b][m][n] = (f32x4){0.f, 0.f, 0.f, 0.f};
        cur = nxt; cA = nA; cB = nB; ++ui;
    }
    PG8_WAIT_V(0);
    if (wr == 0) PG8_BAR;
    PG8_BAR;
#undef PG8_SA
#undef PG8_SB
#undef PG8_STAGE
#undef PG8_LDA
#undef PG8_LDB
#undef PG8_MMA
#undef PG8_WAIT_V
#undef PG8_WAIT_L
#undef PG8_BAR
#undef PG8_SCHED
}

typedef f32x4 AccT[2][2][4][2];

struct EpiIn {
    static constexpr bool PERM = true;
    bf16_t* us5; bf16_t* xg;
    __device__ __forceinline__ void operator()(const AccT& acc, const Unit& u, int wr, int wc, int fr, int fq) const {
#pragma unroll
        for (int ai = 0; ai < 2; ++ai)
#pragma unroll
            for (int m = 0; m < 4; ++m) {
                const int row = u.pm * BM + ai * HALF + wr * 64 + m * 16 + fr;
#pragma unroll
                for (int bj = 0; bj < 2; ++bj) {
                    const int col0 = u.pn * BM + bj * HALF + wc * 32 + 8 * fq;
                    const f32x4 v0 = acc[ai][bj][m][0], v1 = acc[ai][bj][m][1];
                    u32x4 w; w.x = cvt_pk_bf16(v0[0], v0[1]); w.y = cvt_pk_bf16(v0[2], v0[3]); w.z = cvt_pk_bf16(v1[0], v1[1]); w.w = cvt_pk_bf16(v1[2], v1[3]);
                    if (u.pn < 2) { const int g = col0 >> 4, p0 = col0 & 15, mr = row >> 5, s = row & 31;
                        *(u32x4*)(us5 + ((size_t)g * MSP + mr) * K3 + s * 16 + p0) = w; }
                    else *(u32x4*)(xg + (size_t)row * 1024 + (col0 - 512)) = w;
                }
            }
    }
};
struct EpiHloc {
    static constexpr bool PERM = false;
    float* hloc;
    __device__ __forceinline__ void operator()(const AccT& acc, const Unit& u, int wr, int wc, int fr, int fq) const {
#pragma unroll
        for (int ai = 0; ai < 2; ++ai)
#pragma unroll
            for (int m = 0; m < 4; ++m) {
                const int row = u.pm * BM + ai * HALF + wr * 64 + m * 16 + fr;
                if (row < MS) {
                    float* rp = hloc + ((size_t)u.g * MS + row) * 256 + wc * 32 + 4 * fq;
#pragma unroll
                    for (int bj = 0; bj < 2; ++bj)
#pragma unroll
                        for (int n = 0; n < 2; ++n) *(f32x4*)(rp + bj * HALF + n * 16) = acc[ai][bj][m][n];
                }
            }
    }
};
struct EpiY1 {
    static constexpr bool PERM = true;
    bf16_t* y1;
    __device__ __forceinline__ void operator()(const AccT& acc, const Unit& u, int wr, int wc, int fr, int fq) const {
#pragma unroll
        for (int ai = 0; ai < 2; ++ai)
#pragma unroll
            for (int m = 0; m < 4; ++m) {
                const int row = u.pm * BM + ai * HALF + wr * 64 + m * 16 + fr;
                if (row < MS) {
#pragma unroll
                    for (int bj = 0; bj < 2; ++bj) {
                        const int col0 = u.pn * BM + bj * HALF + wc * 32 + 8 * fq, t = col0 >> 4, q0 = col0 & 15;
                        const f32x4 v0 = acc[ai][bj][m][0], v1 = acc[ai][bj][m][1];
                        u32x4 w; w.x = cvt_pk_bf16(gelu_tanh(v0[0]), gelu_tanh(v0[1])); w.y = cvt_pk_bf16(gelu_tanh(v0[2]), gelu_tanh(v0[3]));
                        w.z = cvt_pk_bf16(gelu_tanh(v1[0]), gelu_tanh(v1[1])); w.w = cvt_pk_bf16(gelu_tanh(v1[2]), gelu_tanh(v1[3]));
                        *(u32x4*)(y1 + ((size_t)row * TS + t) * 512 + u.g * 16 + q0) = w;
                    }
                }
            }
    }
};
struct EpiGlu {
    static constexpr bool PERM = true;
    const bf16_t* y1; bf16_t* y; const float* bias;
    __device__ __forceinline__ void operator()(const AccT& acc, const Unit& u, int wr, int wc, int fr, int fq) const {
#pragma unroll
        for (int bj = 0; bj < 2; ++bj) {
            const int col0 = u.pn * BM + bj * HALF + wc * 32 + 8 * fq;
            const f32x4 b0 = *(const f32x4*)(bias + col0), b1 = *(const f32x4*)(bias + col0 + 4);
#pragma unroll
            for (int ai = 0; ai < 2; ++ai)
#pragma unroll
                for (int m = 0; m < 4; ++m) {
                    const int row = u.pm * BM + ai * HALF + wr * 64 + m * 16 + fr;
                    const u32x4 yv = *(const u32x4*)(y1 + (size_t)row * 512 + col0);
                    const f32x4 v0 = acc[ai][bj][m][0] + b0, v1 = acc[ai][bj][m][1] + b1;
                    u32x4 w;
                    w.x = cvt_pk_bf16(bf_lo(yv.x) * sigmoidf_(v0[0]), bf_hi(yv.x) * sigmoidf_(v0[1]));
                    w.y = cvt_pk_bf16(bf_lo(yv.y) * sigmoidf_(v0[2]), bf_hi(yv.y) * sigmoidf_(v0[3]));
                    w.z = cvt_pk_bf16(bf_lo(yv.z) * sigmoidf_(v1[0]), bf_hi(yv.z) * sigmoidf_(v1[1]));
                    w.w = cvt_pk_bf16(bf_lo(yv.w) * sigmoidf_(v1[2]), bf_hi(yv.w) * sigmoidf_(v1[3]));
                    *(u32x4*)(y + (size_t)row * 1024 + col0) = w;
                }
        }
    }
};
struct EpiOut {
    static constexpr bool PERM = true;
    bf16_t* o; float* rowss;
    __device__ __forceinline__ void operator()(const AccT& acc, const Unit& u, int wr, int wc, int fr, int fq) const {
#pragma unroll
        for (int ai = 0; ai < 2; ++ai)
#pragma unroll
            for (int m = 0; m < 4; ++m) {
                const int row = u.pm * BM + ai * HALF + wr * 64 + m * 16 + fr;
                float s = 0.f;
#pragma unroll
                for (int bj = 0; bj < 2; ++bj) {
                    const int col0 = u.pn * BM + bj * HALF + wc * 32 + 8 * fq;
                    const f32x4 v0 = acc[ai][bj][m][0], v1 = acc[ai][bj][m][1];
                    s += (v0[0] * v0[0] + v0[1] * v0[1]) + (v0[2] * v0[2] + v0[3] * v0[3]) + (v1[0] * v1[0] + v1[1] * v1[1]) + (v1[2] * v1[2] + v1[3] * v1[3]);
                    u32x4 w; w.x = cvt_pk_bf16(v0[0], v0[1]); w.y = cvt_pk_bf16(v0[2], v0[3]); w.z = cvt_pk_bf16(v1[0], v1[1]); w.w = cvt_pk_bf16(v1[2], v1[3]);
                    *(u32x4*)(o + (size_t)row * 1024 + col0) = w;
                }
                s += __shfl_xor(s, 16); s += __shfl_xor(s, 32);
                if (fq == 0) rowss[(size_t)row * 16 + u.pn * 4 + wc] = s;
            }
    }
};
struct EpiFfn {
    static constexpr bool PERM = true;
    bf16_t* aff;
    __device__ __forceinline__ void operator()(const AccT& acc, const Unit& u, int wr, int wc, int fr, int fq) const {
#pragma unroll
        for (int ai = 0; ai < 2; ++ai)
#pragma unroll
            for (int m = 0; m < 4; ++m) {
                const int row = u.pm * BM + ai * HALF + wr * 64 + m * 16 + fr;
                const f32x4 g0 = acc[ai][0][m][0], g1 = acc[ai][0][m][1], u0 = acc[ai][1][m][0], u1 = acc[ai][1][m][1];
                u32x4 w;
                w.x = cvt_pk_bf16(siluf_(g0[0]) * u0[0], siluf_(g0[1]) * u0[1]); w.y = cvt_pk_bf16(siluf_(g0[2]) * u0[2], siluf_(g0[3]) * u0[3]);
                w.z = cvt_pk_bf16(siluf_(g1[0]) * u1[0], siluf_(g1[1]) * u1[1]); w.w = cvt_pk_bf16(siluf_(g1[2]) * u1[2], siluf_(g1[3]) * u1[3]);
                *(u32x4*)(aff + (size_t)row * DFF + u.pn * 128 + wc * 32 + 8 * fq) = w;
            }
    }
};

__device__ void phase_mod(KArgP a, unsigned char* ws, LAS unsigned char* lds) {
    const int tid = fresh_tid(), lane = tid & 63, wv = tid >> 6;
    LAS float* sc = (LAS float*)lds;
    LAS float* red = sc + 9216;
    for (int idx = tid; idx < 9216; idx += 512) { const int bb = idx >> 10, k = idx & 1023; const float v = bb < 8 ? a->in[1][bb * 1024 + k] : a->in[3][k]; sc[idx] = siluf_(v); }
    __syncthreads();
    float* mod = (float*)(ws + WS_MOD);
    for (int u = blockIdx.x; u < 384; u += gridDim.x) {
        const int l = u / 96, jg = u % 96, j = jg * 64 + lane;
        const float* w = a->in[4] + ((size_t)l * 1024 + wv * 128) * 6144 + j;
        float acc[9];
#pragma unroll
        for (int bb = 0; bb < 9; ++bb) acc[bb] = 0.f;
        for (int k0 = 0; k0 < 128; k0 += 8) {
            float wv8[8];
#pragma unroll
            for (int e = 0; e < 8; ++e) wv8[e] = w[(size_t)(k0 + e) * 6144];
#pragma unroll
            for (int e = 0; e < 8; ++e)
#pragma unroll
                for (int bb = 0; bb < 9; ++bb) acc[bb] += sc[bb * 1024 + wv * 128 + k0 + e] * wv8[e];
        }
#pragma unroll
        for (int bb = 0; bb < 9; ++bb) red[(wv * 9 + bb) * 64 + lane] = acc[bb];
        __syncthreads();
        for (int o = tid; o < 576; o += 512) { const int bb = o >> 6, ln = o & 63; float s = a->in[5][l * 6144 + jg * 64 + ln];
#pragma unroll
            for (int w8 = 0; w8 < 8; ++w8) s += red[(w8 * 9 + bb) * 64 + ln];
            mod[((size_t)l * 9 + bb) * 6144 + jg * 64 + ln] = s; }
        __syncthreads();
    }
}

__device__ __forceinline__ void transpose_tile(const float* src, int N, bf16_t* dst, int Kd, int k0, int n0, int drow0, LAS float* t) {
    const int tid = fresh_tid();
#pragma unroll
    for (int i = 0; i < 16; ++i) { const int k = i * 8 + (tid >> 6), n = tid & 63; t[k * 65 + n] = src[(size_t)(k0 + k) * N + n0 + n]; }
    __syncthreads();
#pragma unroll
    for (int i = 0; i < 8; ++i) { const int n = i * 8 + (tid >> 6), kk = (tid & 63) * 2;
        *(unsigned*)(dst + (size_t)(drow0 + n) * Kd + k0 + kk) = cvt_pk_bf16(t[kk * 65 + n], t[(kk + 1) * 65 + n]); }
    __syncthreads();
}
__device__ void phase_wconv(KArgP a, unsigned char* ws, LAS unsigned char* lds) {
    LAS float* t = (LAS float*)lds;
    for (int T = blockIdx.x; T < 4 * 1408; T += gridDim.x) {
        const int l = T / 1408; int r = T % 1408;
        unsigned char* wl = ws + WS_WL + (size_t)l * WL_SIZE;
        if (r < 192) { const int kt = r / 24, nt = r % 24; transpose_tile(a->in[7] + (size_t)l * 1024 * 1536, 1536, (bf16_t*)(wl + WL_IN), 1024, kt * 128, nt * 64, nt * 64, t); }
        else if (r < 224) { r -= 192; const int kt = r / 8, nt = r % 8; transpose_tile(a->in[16] + (size_t)l * 512 * 512, 512, (bf16_t*)(wl + WL_GLU), 512, kt * 128, nt * 64, nt * 64, t); }
        else if (r < 352) { r -= 224; const int kt = r / 16, nt = r % 16; transpose_tile(a->in[25] + (size_t)l * 1024 * 1024, 1024, (bf16_t*)(wl + WL_OUT), 1024, kt * 128, nt * 64, nt * 64, t); }
        else if (r < 1056) { r -= 352; const int kt = r / 88, nt = r % 88; const int n0 = nt * 64;
            const int drow0 = n0 < DFF ? 256 * (n0 / 128) + (n0 % 128) : 256 * ((n0 - DFF) / 128) + 128 + ((n0 - DFF) % 128);
            transpose_tile(a->in[26] + (size_t)l * 1024 * 5632, 5632, (bf16_t*)(wl + WL_FI), 1024, kt * 128, n0, drow0, t); }
        else { r -= 1056; const int kt = r / 16, nt = r % 16; transpose_tile(a->in[27] + (size_t)l * DFF * 1024, 1024, (bf16_t*)(wl + WL_FO), DFF, kt * 128, nt * 64, nt * 64, t); }
    }
    for (int idx = fresh_bid() * 512 + fresh_tid(); idx < 4 * 8 * 4 * 64 * 64; idx += gridDim.x * 512) {
        const int j = idx & 63, k = (idx >> 6) & 63, nb = (idx >> 12) & 3, h = (idx >> 14) & 7, l = idx >> 17;
        const float* src = (nb & 1) ? a->in[22] : a->in[20];
        const float v = src[((((size_t)l * 2 + (nb >> 1)) * 8 + h) * 64 + k) * 64 + j];
        bf16_t* dst = (bf16_t*)(ws + WS_WL + (size_t)l * WL_SIZE + WL_LRU);
        dst[((size_t)h * 256 + nb * 64 + j) * 64 + k] = (bf16_t)(cvt_pk_bf16(v, 0.f) & 0xffffu);
    }
}

__device__ void s5tab_group(KArgP a, unsigned char* ws, LAS unsigned char* lds, int layer, int g) {
    const int tid = fresh_tid();
    LAS f32x2* abp = (LAS f32x2*)lds;
    LAS f32x2* bbv = (LAS f32x2*)(lds + 33792);
    LAS f32x2* ccv = (LAS f32x2*)(lds + 50176);
    LAS float* kt = (LAS float*)(lds + 66560);
    if (tid < 128) {
        const int d = tid >> 6, n = tid & 63, base = (layer * 2 + d) * 32 + g;
        const float dt = expf(a->in[10][base]);
        const float are = a->in[8][base * 64 + n], aim = a->in[9][base * 64 + n];
        for (int tau = 0; tau <= 32; ++tau) {
            const float mag = expf(are * dt * (float)tau);
            float rev = aim * dt * (float)tau * 0.15915494309189535f; rev -= rintf(rev);
            const float ang = rev * 6.283185307179586f;
            abp[(d * 64 + n) * 33 + tau] = mk2(mag * cosf(ang), mag * sinf(ang));
        }
        const float zr = are * dt; float rev = aim * dt * 0.15915494309189535f; rev -= rintf(rev); const float zi = rev * 6.283185307179586f;
        const float em1 = expm1f(zr), cz = cosf(zi), sz = sinf(zi), s2 = sinf(0.5f * zi);
        const float nr = em1 * cz - 2.f * s2 * s2, abim = (em1 + 1.f) * sz;
        const float den = are * are + aim * aim;
        const float fre = (nr * are + abim * aim) / den, fim = (abim * are - nr * aim) / den;
        for (int p = 0; p < 16; ++p) {
            const float br = a->in[11][((size_t)base * 64 + n) * 16 + p], bi = a->in[12][((size_t)base * 64 + n) * 16 + p];
            bbv[(d * 64 + n) * 16 + p] = mk2(fre * br - fim * bi, fre * bi + fim * br);
        }
        for (int q = 0; q < 16; ++q) ccv[(d * 16 + q) * 64 + n] = mk2(a->in[13][((size_t)base * 16 + q) * 64 + n], a->in[14][((size_t)base * 16 + q) * 64 + n]);
        ((f32x2*)(ws + WS_AT))[(g * 2 + d) * 64 + n] = abp[(d * 64 + n) * 33 + 32];
    }
    __syncthreads();
    for (int it = 0; it < 2; ++it) {
        const int combo = tid + it * 512, d = combo >> 9, tau = (combo >> 4) & 31, q = combo & 15;
        float acc[16];
#pragma unroll
        for (int p = 0; p < 16; ++p) acc[p] = 0.f;
        for (int n = 0; n < 64; ++n) {
            const f32x2 c = ccv[(d * 16 + q) * 64 + n], pw = abp[(d * 64 + n) * 33 + tau];
            const float wr_ = c.x * pw.x - c.y * pw.y, wi_ = c.x * pw.y + c.y * pw.x;
#pragma unroll
            for (int p = 0; p < 16; ++p) { const f32x2 bv = bbv[(d * 64 + n) * 16 + p]; acc[p] += wr_ * bv.x - wi_ * bv.y; }
        }
#pragma unroll
        for (int p = 0; p < 16; ++p) kt[((d * 32 + tau) * 16 + q) * 16 + p] = acc[p];
    }
    __syncthreads();
    bf16_t* bt3 = (bf16_t*)(ws + WS_BT3) + (size_t)g * 512 * K3;
    bf16_t* bt1 = (bf16_t*)(ws + WS_BT1) + (size_t)g * 256 * K1;
    const float* dvec = a->in[15] + layer * 512 + g * 16;
    for (int i = 0; i < 64; ++i) {
        const int it = tid + 512 * i, row = it >> 6, s = (it >> 1) & 31, ph = it & 1, t = row >> 4, q = row & 15;
        float v[8];
#pragma unroll
        for (int e = 0; e < 8; ++e) { const int p = ph * 8 + e; float x = 0.f;
            if (s <= t) x += kt[(((t - s)) * 16 + q) * 16 + p];
            if (s >= t) x += kt[((32 + (s - t)) * 16 + q) * 16 + p];
            if (s == t && p == q) x += dvec[q];
            v[e] = x; }
        u32x4 w; w.x = cvt_pk_bf16(v[0], v[1]); w.y = cvt_pk_bf16(v[2], v[3]); w.z = cvt_pk_bf16(v[4], v[5]); w.w = cvt_pk_bf16(v[6], v[7]);
        *(u32x4*)(bt3 + (size_t)row * K3 + s * 16 + ph * 8) = w;
    }
    for (int i = 0; i < 32; ++i) {
        const int it = tid + 512 * i, row = it >> 5, c8 = (it & 31) * 8, t = row >> 4, q = row & 15, d = c8 >> 7, n0 = (c8 & 127) >> 1;
        const int pw = d == 0 ? t + 1 : 32 - t;
        float v[8];
#pragma unroll
        for (int e = 0; e < 4; ++e) { const f32x2 c = ccv[(d * 16 + q) * 64 + n0 + e], pa = abp[(d * 64 + n0 + e) * 33 + pw];
            v[2 * e] = c.x * pa.x - c.y * pa.y; v[2 * e + 1] = -(c.x * pa.y + c.y * pa.x); }
        u32x4 w; w.x = cvt_pk_bf16(v[0], v[1]); w.y = cvt_pk_bf16(v[2], v[3]); w.z = cvt_pk_bf16(v[4], v[5]); w.w = cvt_pk_bf16(v[6], v[7]);
        *(u32x4*)(bt3 + (size_t)row * K3 + 512 + c8) = w;
    }
    for (int i = 0; i < 32; ++i) {
        const int it = tid + 512 * i, row = it >> 6, k8 = (it & 63) * 8, s = k8 >> 4, p0 = k8 & 15, d = row >> 7, n = (row & 127) >> 1, ci = row & 1;
        const int pw = d == 0 ? 31 - s : s;
        const f32x2 pa = abp[(d * 64 + n) * 33 + pw];
        float v[8];
#pragma unroll
        for (int e = 0; e < 8; ++e) { const f32x2 bv = bbv[(d * 64 + n) * 16 + p0 + e]; v[e] = ci ? (pa.x * bv.y + pa.y * bv.x) : (pa.x * bv.x - pa.y * bv.y); }
        u32x4 w; w.x = cvt_pk_bf16(v[0], v[1]); w.y = cvt_pk_bf16(v[2], v[3]); w.z = cvt_pk_bf16(v[4], v[5]); w.w = cvt_pk_bf16(v[6], v[7]);
        *(u32x4*)(bt1 + (size_t)row * K1 + k8) = w;
    }
    __syncthreads();
}

template <int MODE>
__device__ void phase_norm(KArgP a, unsigned char* ws, int layer) {
    const int tid = fresh_tid();
    const int lane = tid & 63, wid = tid >> 6;
    const int gw = fresh_bid() * 8 + wid, GW = gridDim.x * 8;
    const float* mod = (const float*)(ws + WS_MOD);
    const float* gains = a->in[6];
    const bool from_input = (MODE == 0) || (MODE == 1 && layer == 0);
    for (int R = gw; R < MTOK; R += GW) {
        const int b = R / POS, pos = R % POS; const bool isctx = pos < CTXL; const int cb = isctx ? 8 : b;
        const float* xsrc; float* xdst;
        if (isctx) { const size_t o = ((size_t)b * CTXL + pos) * D; xdst = (float*)(ws + WS_CTXR) + o; xsrc = from_input ? a->in[2] + o : xdst; }
        else { const size_t o = ((size_t)b * SEQ + (pos - CTXL)) * D; xdst = a->out + o; xsrc = from_input ? a->in[0] + o : xdst; }
        float x[16];
#pragma unroll
        for (int i = 0; i < 2; ++i) { const int c0 = lane * 8 + 512 * i; const f32x4 p = *(const f32x4*)(xsrc + c0), q = *(const f32x4*)(xsrc + c0 + 4);
            x[8 * i + 0] = p[0]; x[8 * i + 1] = p[1]; x[8 * i + 2] = p[2]; x[8 * i + 3] = p[3]; x[8 * i + 4] = q[0]; x[8 * i + 5] = q[1]; x[8 * i + 6] = q[2]; x[8 * i + 7] = q[3]; }
        if (MODE != 0) {
            const float* rs = (const float*)(ws + WS_ROWSS) + (size_t)R * 16;
            const f32x4 r0 = *(const f32x4*)rs, r1 = *(const f32x4*)(rs + 4), r2 = *(const f32x4*)(rs + 8), r3 = *(const f32x4*)(rs + 12);
            const float ss = ((r0[0] + r0[1]) + (r0[2] + r0[3])) + ((r1[0] + r1[1]) + (r1[2] + r1[3])) + ((r2[0] + r2[1]) + (r2[2] + r2[3])) + ((r3[0] + r3[1]) + (r3[2] + r3[3]));
            const float rstd = rsqrtf(ss * (1.0f / 1024.0f) + EPS);
            const bf16_t* o = (const bf16_t*)(ws + WS_R3) + (size_t)R * D;
            const float* gate = mod + ((size_t)layer * 9 + cb) * 6144 + (MODE == 1 ? 2 : 5) * 1024;
            const float* gpost = gains + ((size_t)layer * 4 + (MODE == 1 ? 1 : 3)) * 1024;
#pragma unroll
            for (int i = 0; i < 2; ++i) { const int c0 = lane * 8 + 512 * i; const u32x4 ov = *(const u32x4*)(o + c0);
                const float of[8] = {bf_lo(ov.x), bf_hi(ov.x), bf_lo(ov.y), bf_hi(ov.y), bf_lo(ov.z), bf_hi(ov.z), bf_lo(ov.w), bf_hi(ov.w)};
                const f32x4 g0 = *(const f32x4*)(gate + c0), g1 = *(const f32x4*)(gate + c0 + 4), p0 = *(const f32x4*)(gpost + c0), p1 = *(const f32x4*)(gpost + c0 + 4);
#pragma unroll
                for (int e = 0; e < 4; ++e) { x[8 * i + e] += g0[e] * ((of[e] * rstd) * p0[e]); x[8 * i + 4 + e] += g1[e] * ((of[4 + e] * rstd) * p1[e]); }
                *(f32x4*)(xdst + c0) = (f32x4){x[8 * i], x[8 * i + 1], x[8 * i + 2], x[8 * i + 3]}; *(f32x4*)(xdst + c0 + 4) = (f32x4){x[8 * i + 4], x[8 * i + 5], x[8 * i + 6], x[8 * i + 7]}; }
        }
        if (MODE == 2 && layer == DEPTH - 1) continue;
        float s2 = 0.f;
#pragma unroll
        for (int e = 0; e < 16; ++e) s2 += x[e] * x[e];
#pragma unroll
        for (int off = 32; off >= 1; off >>= 1) s2 += __shfl_xor(s2, off);
        const float rstd2 = rsqrtf(s2 * (1.0f / 1024.0f) + EPS);
        const int ln = MODE == 2 ? layer + 1 : layer;
        const float* gpre = gains + ((size_t)ln * 4 + (MODE == 1 ? 2 : 0)) * 1024;
        const float* shp = mod + ((size_t)ln * 9 + cb) * 6144 + (MODE == 1 ? 3 : 0) * 1024;
        const float* scp = shp + 1024;
        bf16_t* h = (bf16_t*)(ws + WS_R2) + (size_t)R * D;
#pragma unroll
        for (int i = 0; i < 2; ++i) { const int c0 = lane * 8 + 512 * i; float hv[8];
            const f32x4 g0 = *(const f32x4*)(gpre + c0), g1 = *(const f32x4*)(gpre + c0 + 4), s0 = *(const f32x4*)(shp + c0), s1 = *(const f32x4*)(shp + c0 + 4), c0v = *(const f32x4*)(scp + c0), c1v = *(const f32x4*)(scp + c0 + 4);
#pragma unroll
            for (int e = 0; e < 4; ++e) { hv[e] = ((x[8 * i + e] * rstd2) * g0[e]) * (1.f + c0v[e]) + s0[e]; hv[4 + e] = ((x[8 * i + 4 + e] * rstd2) * g1[e]) * (1.f + c1v[e]) + s1[e]; }
            u32x4 w; w.x = cvt_pk_bf16(hv[0], hv[1]); w.y = cvt_pk_bf16(hv[2], hv[3]); w.z = cvt_pk_bf16(hv[4], hv[5]); w.w = cvt_pk_bf16(hv[6], hv[7]);
            *(u32x4*)(h + c0) = w; }
    }
}

__device__ __forceinline__ int lru_tok(int b, int cl, int j) {
    if (cl < 4) { const int p = cl * 64 + j; return (p >= 0 && p < CTXL) ? b * POS + p : -1; }
    const int jj = (cl - 4) * 64 + j; if (jj < 0 || jj >= SEQ) return -1;
    return b * POS + CTXL + (jj & 63) * 64 + (jj >> 6);
}
template <int MODE>
__device__ void lru_unit(KArgP a, unsigned char* ws, LAS unsigned char* lds, int layer, int b, int cl, int head) {
    const int tid = fresh_tid(), lane = tid & 63, wv = tid >> 6;
    LAS float* xr_s = (LAS float*)lds;
    LAS float* xcf = (LAS float*)(lds + 17408);
    LAS bf16_t* xcb = (LAS bf16_t*)(lds + 33792);
    LAS f32x2* ab = (LAS f32x2*)(lds + 43008);
    LAS f32x2* sagg = (LAS f32x2*)(lds + 108544);
    const bf16_t* xg = (const bf16_t*)(ws + WS_XG);
    for (int idx = tid; idx < 67 * 8; idx += 512) {
        const int pi = idx >> 3, c8 = (idx & 7) * 8, tok = lru_tok(b, cl, pi - 2);
        u32x4 v = (u32x4){0u, 0u, 0u, 0u};
        if (tok >= 0) v = *(const u32x4*)(xg + (size_t)tok * 1024 + head * 64 + c8);
        LAS float* dp = xr_s + pi * 64 + c8;
        dp[0] = bf_lo(v.x); dp[1] = bf_hi(v.x); dp[2] = bf_lo(v.y); dp[3] = bf_hi(v.y); dp[4] = bf_lo(v.z); dp[5] = bf_hi(v.z); dp[6] = bf_lo(v.w); dp[7] = bf_hi(v.w);
    }
    __syncthreads();
    {
        const int t = tid >> 3, c8 = (tid & 7) * 8;
        const float* cw = a->in[18] + (size_t)layer * 4 * 512 + head * 64 + c8;
        const float* cbias = a->in[19] + layer * 512 + head * 64 + c8;
#pragma unroll
        for (int e = 0; e < 8; ++e) {
            float v = cbias[e];
#pragma unroll
            for (int k = 0; k < 4; ++k) v += cw[k * 512 + e] * xr_s[(t + k) * 64 + c8 + e];
            xcf[t * 64 + c8 + e] = v;
            xcb[t * 72 + c8 + e] = (bf16_t)(cvt_pk_bf16(v, 0.f) & 0xffffu);
        }
    }
    __syncthreads();
    {
        const int d = wv >> 2, cb = wv & 3, fr = lane & 15, fq = lane >> 4;
        const bf16_t* Wl = (const bf16_t*)(ws + WS_WL + (size_t)layer * WL_SIZE + WL_LRU) + (size_t)head * 256 * 64;
        bf16x8 Bf[2][2], Af[4][2];
#pragma unroll
        for (int gt = 0; gt < 2; ++gt)
#pragma unroll
            for (int ks = 0; ks < 2; ++ks) Bf[gt][ks] = *(const bf16x8*)(Wl + (size_t)((d * 2 + gt) * 64 + cb * 16 + fr) * 64 + ks * 32 + fq * 8);
#pragma unroll
        for (int m = 0; m < 4; ++m)
#pragma unroll
            for (int ks = 0; ks < 2; ++ks) Af[m][ks] = *(const LAS bf16x8*)(xcb + (16 * m + fr) * 72 + ks * 32 + fq * 8);
        f32x4 acc[2][4];
#pragma unroll
        for (int gt = 0; gt < 2; ++gt)
#pragma unroll
            for (int m = 0; m < 4; ++m) { acc[gt][m] = (f32x4){0.f, 0.f, 0.f, 0.f};
#pragma unroll
                for (int ks = 0; ks < 2; ++ks) acc[gt][m] = __builtin_amdgcn_mfma_f32_16x16x32_bf16(Af[m][ks], Bf[gt][ks], acc[gt][m], 0, 0, 0); }
        const int ch = cb * 16 + fr, hc = head * 64 + ch, pidx = (layer * 2 + d) * 512 + hc;
        const float brg = a->in[21][pidx], big = a->in[23][pidx], lam = a->in[24][pidx];
        const float ex = __expf(-lam);
        const float sp = ex < 0.1f ? ex * (1.f - ex * (0.5f - ex * (0.33333333f - ex * 0.25f))) : __logf(1.f + ex);
#pragma unroll
        for (int m = 0; m < 4; ++m)
#pragma unroll
            for (int rg = 0; rg < 4; ++rg) {
                const int t = 16 * m + 4 * fq + rg;
                const float r = sigmoidf_(acc[0][m][rg] + brg), ig = sigmoidf_(acc[1][m][rg] + big);
                const float la = -8.0f * r * sp, av = __expf(la), z = 2.f * la;
                const float om = z > -0.3f ? -z * (1.f + 0.5f * z * (1.f + 0.33333333f * z * (1.f + 0.25f * z * (1.f + 0.2f * z * (1.f + 0.16666667f * z))))) : 1.f - __expf(z);
                const float bv = sqrtf(om) * ig * xcf[t * 64 + ch];
                ab[(d * 64 + t) * 64 + ch] = mk2(av, bv);
            }
    }
    __syncthreads();
    const int seg = tid >> 7, d2 = (tid >> 6) & 1, ch2 = tid & 63;
    {
        float A = 1.f, H = 0.f;
#pragma unroll
        for (int q = 0; q < 16; ++q) { const int t = seg * 16 + (d2 ? 15 - q : q); const f32x2 v = ab[(d2 * 64 + t) * 64 + ch2]; H = v.x * H + v.y; A *= v.x; }
        sagg[(seg * 2 + d2) * 64 + ch2] = mk2(A, H);
    }
    __syncthreads();
    const size_t gidx = ((size_t)(b * LCH + cl) * 2 + d2) * 512 + head * 64 + ch2;
    if (MODE == 0) {
        if (seg == 0) {
            float A = 1.f, H = 0.f;
#pragma unroll
            for (int s = 0; s < 4; ++s) { const f32x2 v = sagg[((d2 ? 3 - s : s) * 2 + d2) * 64 + ch2]; H = v.x * H + v.y; A *= v.x; }
            ((f32x2*)(ws + WS_LAGG))[gidx] = mk2(A, H);
        }
    } else {
        float H = ((const float*)(ws + WS_LHIN))[gidx];
        if (d2 == 0) { for (int s = 0; s < seg; ++s) { const f32x2 v = sagg[(s * 2) * 64 + ch2]; H = v.x * H + v.y; } }
        else { for (int s = 3; s > seg; --s) { const f32x2 v = sagg[(s * 2 + 1) * 64 + ch2]; H = v.x * H + v.y; } }
#pragma unroll
        for (int q = 0; q < 16; ++q) { const int t = seg * 16 + (d2 ? 15 - q : q); const f32x2 v = ab[(d2 * 64 + t) * 64 + ch2]; H = v.x * H + v.y; ab[(d2 * 64 + t) * 64 + ch2].y = H; }
        __syncthreads();
        const int t = tid >> 3, c8 = (tid & 7) * 8, tok = lru_tok(b, cl, t);
        const u32x4 gv = *(const u32x4*)(xg + (size_t)tok * 1024 + 512 + head * 64 + c8);
        const float gr[8] = {bf_lo(gv.x), bf_hi(gv.x), bf_lo(gv.y), bf_hi(gv.y), bf_lo(gv.z), bf_hi(gv.z), bf_lo(gv.w), bf_hi(gv.w)};
        float o[8];
#pragma unroll
        for (int e = 0; e < 8; ++e) o[e] = (ab[t * 64 + c8 + e].y + ab[(64 + t) * 64 + c8 + e].y) * gelu_tanh(gr[e]);
        u32x4 w; w.x = cvt_pk_bf16(o[0], o[1]); w.y = cvt_pk_bf16(o[2], o[3]); w.z = cvt_pk_bf16(o[4], o[5]); w.w = cvt_pk_bf16(o[6], o[7]);
        *(u32x4*)((bf16_t*)(ws + WS_R2) + (size_t)tok * 1024 + 512 + head * 64 + c8) = w;
    }
    __syncthreads();
}
template <int MODE>
__device__ void phase_lru(KArgP a, unsigned char* ws, LAS unsigned char* lds, int layer) {
    for (int U = (int)(gridDim.x - 1 - fresh_bid()); U < NB * LCH * NH; U += gridDim.x) {
        const int head = U & 7, bc = U >> 3; lru_unit<MODE>(a, ws, lds, layer, bc / LCH, bc % LCH, head);
    }
}

__device__ void phase_carry(unsigned char* ws) {
    const int tid = fresh_tid(), bid = fresh_bid();
    const int lane = tid & 63, wid = tid >> 6;
    for (int item = wid * gridDim.x + bid; item < 640; item += 8 * gridDim.x) {
        if (item < 512) {
            const int g = item >> 4, b = (item >> 1) & 7, d = item & 1, n = lane;
            const f32x2 aT = ((const f32x2*)(ws + WS_AT))[(g * 2 + d) * 64 + n];
            const f32x2* hl = (const f32x2*)(ws + WS_HLOC) + ((size_t)(g * MS + b * SCH) * 256 + d * 128 + 2 * n) / 2;
            unsigned* hin = (unsigned*)(ws + WS_US5) + ((size_t)(g * MSP + b * SCH) * K3 + 512 + d * 128 + 2 * n) / 2;
            float hr = 0.f, hi = 0.f;
            for (int ib = 0; ib < SCH / 8; ++ib) {
                f32x2 L[8];
#pragma unroll
                for (int e = 0; e < 8; ++e) { const int i = ib * 8 + e, c = d == 0 ? i : (i < 8 ? 7 - i : 143 - i); L[e] = hl[(size_t)c * 128]; }
#pragma unroll
                for (int e = 0; e < 8; ++e) { const int i = ib * 8 + e, c = d == 0 ? i : (i < 8 ? 7 - i : 143 - i);
                    hin[(size_t)c * (K3 / 2)] = cvt_pk_bf16(hr, hi);
                    const float nr = aT.x * hr - aT.y * hi + L[e].x, ni = aT.x * hi + aT.y * hr + L[e].y; hr = nr; hi = ni; }
            }
        } else {
            const int tl = (item - 512) * 64 + lane, b = tl >> 10, d = (tl >> 9) & 1, ch = tl & 511;
            const f32x2* ag = (const f32x2*)(ws + WS_LAGG) + ((size_t)b * LCH * 2 + d) * 512 + ch;
            float* hin = (float*)(ws + WS_LHIN) + ((size_t)b * LCH * 2 + d) * 512 + ch;
            float H = 0.f;
            for (int ib = 0; ib < LCH / 4; ++ib) {
                f32x2 L[4];
#pragma unroll
                for (int e = 0; e < 4; ++e) { const int i = ib * 4 + e, cl = d == 0 ? i : (i < 4 ? 3 - i : 71 - i); L[e] = ag[(size_t)cl * 1024]; }
#pragma unroll
                for (int e = 0; e < 4; ++e) { const int i = ib * 4 + e, cl = d == 0 ? i : (i < 4 ? 3 - i : 71 - i); hin[(size_t)cl * 1024] = H; H = L[e].x * H + L[e].y; }
            }
        }
    }
}

__global__ void __launch_bounds__(512, 2) mega(Args a_unused) {
    extern __shared__ __attribute__((aligned(16))) unsigned char lds_raw[];
    LAS unsigned char* lds = (LAS unsigned char*)lds_raw;
    cg::grid_group grid = cg::this_grid();
    const int G = gridDim.x, c = blockIdx.x;
#define PH_BEGIN KArgP a = kargs(); unsigned char* ws = fresh_ws(); (void)a; (void)ws;

#if PM & 1
    { PH_BEGIN for (int g = c; g < NG; g += G) s5tab_group(a, ws, lds, 0, g); }
#endif
#if PM & 2
    { PH_BEGIN phase_mod(a, ws, lds); }
#endif
#if PM & 4
    { PH_BEGIN phase_wconv(a, ws, lds); }
#endif
    grid.sync();
#if PM & 8
    { PH_BEGIN phase_norm<0>(a, ws, 0); }
#endif
    grid.sync();

#pragma unroll 1
    for (int l = 0; l < DEPTH; ++l) {
#if PM & 16
        { PH_BEGIN unsigned char* wl = ws + WS_WL + (size_t)l * WL_SIZE;
          PlainOrder S; S.init(ws + WS_R2, 1024, wl + WL_IN, 1024, MTOK, DIN, G, c); EpiIn E{(bf16_t*)(ws + WS_US5), (bf16_t*)(ws + WS_XG)};
          gemm_phase<EpiIn, PlainOrder>(lds, 1024, 1024, 1024, S, E); }
#endif
        grid.sync();
#if PM & 32
        { PH_BEGIN BatchOrder S; S.init(ws + WS_US5, K3, (size_t)MSP * K3 * 2, ws + WS_BT1, K1, (size_t)256 * K1 * 2, MSP / BM, 1, NG, G, c); EpiHloc E{(float*)(ws + WS_HLOC)};
          gemm_phase<EpiHloc, BatchOrder>(lds, K3, K1, K1, S, E); }
#endif
#if PM & 2048
        { PH_BEGIN phase_lru<0>(a, ws, lds, l); }
#endif
        grid.sync();
#if PM & 8192
        { PH_BEGIN phase_carry(ws); }
#endif
        grid.sync();
#if PM & 64
        { PH_BEGIN BatchOrder S; S.init(ws + WS_US5, K3, (size_t)MSP * K3 * 2, ws + WS_BT3, K3, (size_t)512 * K3 * 2, MSP / BM, 2, NG, G, c); EpiY1 E{(bf16_t*)(ws + WS_Y1)};
          gemm_phase<EpiY1, BatchOrder>(lds, K3, K3, K3, S, E); }
#endif
#if PM & 4096
        { PH_BEGIN phase_lru<1>(a, ws, lds, l); }
#endif
        grid.sync();
#if PM & 128
        { PH_BEGIN unsigned char* wl = ws + WS_WL + (size_t)l * WL_SIZE;
          PlainOrder S; S.init(ws + WS_Y1, 512, wl + WL_GLU, 512, MTOK, 512, G, c); EpiGlu E{(const bf16_t*)(ws + WS_Y1), (bf16_t*)(ws + WS_R2), a->in[17] + l * 512};
          gemm_phase<EpiGlu, PlainOrder>(lds, 512, 512, 512, S, E); }
#endif
        grid.sync();
#if PM & 256
        { PH_BEGIN unsigned char* wl = ws + WS_WL + (size_t)l * WL_SIZE;
          PlainOrder S; S.init(ws + WS_R2, 1024, wl + WL_OUT, 1024, MTOK, 1024, G, c); EpiOut E{(bf16_t*)(ws + WS_R3), (float*)(ws + WS_ROWSS)};
          gemm_phase<EpiOut, PlainOrder>(lds, 1024, 1024, 1024, S, E); }
#endif
        grid.sync();
#if PM & 1
        { PH_BEGIN if (l + 1 < DEPTH) for (int g = c; g < NG; g += G) s5tab_group(a, ws, lds, l + 1, g); }
#endif
#if PM & 16384
        { PH_BEGIN phase_norm<1>(a, ws, l); }
#endif
        grid.sync();
#if PM & 512
        { PH_BEGIN unsigned char* wl = ws + WS_WL + (size_t)l * WL_SIZE;
          PlainOrder S; S.init(ws + WS_R2, 1024, wl + WL_FI, 1024, MTOK, 2 * DFF, G, c); EpiFfn E{(bf16_t*)(ws + WS_AFF)};
          gemm_phase<EpiFfn, PlainOrder>(lds, 1024, 1024, 1024, S, E); }
#endif
        grid.sync();
#if PM & 1024
        { PH_BEGIN unsigned char* wl = ws + WS_WL + (size_t)l * WL_SIZE;
          PlainOrder S; S.init(ws + WS_AFF, DFF, wl + WL_FO, DFF, MTOK, 1024, G, c); EpiOut E{(bf16_t*)(ws + WS_R3), (float*)(ws + WS_ROWSS)};
          gemm_phase<EpiOut, PlainOrder>(lds, DFF, DFF, DFF, S, E); }
#endif
        grid.sync();
#if PM & 32768
        { PH_BEGIN phase_norm<2>(a, ws, l); }
#endif
        if (l + 1 < DEPTH) grid.sync();
    }
}

extern "C" void kernel_launch(void* const* d_in, const int* in_sizes, int n_in, void* d_out, int out_size, void* d_ws, size_t ws_size, hipStream_t stream) {
    static int grid = 0;
    if (grid == 0) {
        if (n_in != 28 || out_size != NB * SEQ * D || ws_size < WS_END) { fprintf(stderr, "kernel_launch: unexpected shapes (n_in %d, out %d, ws %zu, need %zu)\n", n_in, out_size, ws_size, (size_t)WS_END); grid = -1; return; }
        int dev = 0, cus = 0, per_cu = 0;
        hipGetDevice(&dev); hipDeviceGetAttribute(&cus, hipDeviceAttributeMultiprocessorCount, dev);
        if (hipFuncSetAttribute((const void*)mega, hipFuncAttributeMaxDynamicSharedMemorySize, LDS_BYTES) != hipSuccess) { fprintf(stderr, "kernel_launch: hipFuncSetAttribute failed\n"); grid = -1; return; }
        if (hipOccupancyMaxActiveBlocksPerMultiprocessor(&per_cu, (const void*)mega, 512, LDS_BYTES) != hipSuccess || per_cu < 1) { fprintf(stderr, "kernel_launch: occupancy query says %d\n", per_cu); per_cu = 1; }
        (void)hipGetLastError();
        grid = cus * 1;
        if (grid <= 0) grid = 256;
    }
    if (grid < 0) return;
    Args a{};
    for (int i = 0; i < 28; ++i) a.in[i] = (const float*)d_in[i];
    a.out = (float*)d_out; a.ws = (unsigned char*)d_ws;
    void* args[] = {&a};
    hipError_t e = hipLaunchCooperativeKernel((const void*)mega, dim3(grid), dim3(512), args, LDS_BYTES, stream);
    if (e != hipSuccess) fprintf(stderr, "kernel_launch: cooperative launch failed: %s (grid %d)\n", hipGetErrorString(e), grid);
}
```

```cpp
#include <hip/hip_runtime.h>
#include <hip/hip_cooperative_groups.h>
#include <cstdio>
namespace cg = cooperative_groups;

#define LAS __attribute__((address_space(3)))
#ifndef PM
#define PM 65535
#endif
#ifndef REP_LRU
#define REP_LRU 1
#endif
#ifndef REP_P0
#define REP_P0 1
#endif
#ifndef REP_CARRY
#define REP_CARRY 1
#endif
#ifndef REP_GEMM
#define REP_GEMM 1
#endif
typedef unsigned short bf16_t;
typedef short bf16x8 __attribute__((ext_vector_type(8)));
typedef float f32x4 __attribute__((ext_vector_type(4)));
typedef unsigned u32x4 __attribute__((ext_vector_type(4)));
typedef float f32x2 __attribute__((ext_vector_type(2)));

constexpr int D = 1024, NB = 8, SEQ = 4096, DEPTH = 4, CTXL = 256, POS = CTXL + SEQ, MTOK = NB * POS;
constexpr int DS5 = 512, NG = 32, DLRU = 512, NH = 8, DIN = 1536, DFF = 2816;
constexpr int TS = 32, SCH = POS / TS, MS = NB * SCH, MSP = 1280, K3 = 768, K1 = 512;
constexpr int LCH = 68;
constexpr float EPS = 1e-6f;
constexpr int LDS_BYTES = 147456;

constexpr size_t WS_CTXR = 0;
constexpr size_t WS_MOD = WS_CTXR + (size_t)NB * CTXL * D * 4;
constexpr size_t WS_WL = WS_MOD + 4 * 9 * 6144 * 4;
constexpr size_t WL_IN = 0, WL_GLU = WL_IN + 3145728, WL_OUT = WL_GLU + 524288, WL_FI = WL_OUT + 2097152, WL_FO = WL_FI + 11534336, WL_LRU = WL_FO + 5767168, WL_SIZE = WL_LRU + 262144;
constexpr size_t WS_BT3 = WS_WL + 4 * WL_SIZE;
constexpr size_t WS_BT1 = WS_BT3 + 25165824;
constexpr size_t WS_AT = WS_BT1 + 8388608;
constexpr size_t WS_BIG = WS_AT + 32768;
constexpr size_t WS_US5 = WS_BIG;
constexpr size_t WS_XG = WS_US5 + 62914560;
constexpr size_t WS_HLOC = WS_XG + 71303168;
constexpr size_t WS_Y1 = WS_HLOC + 35651584;
constexpr size_t BIG_SIZE = 205520896;
constexpr size_t WS_AFF = WS_BIG;
constexpr size_t WS_R2 = WS_BIG + BIG_SIZE;
constexpr size_t WS_R3 = WS_R2 + 71303168;
constexpr size_t WS_ROWSS = WS_R3 + 71303168;
constexpr size_t WS_LAGG = WS_ROWSS + 2228224;
constexpr size_t WS_LHIN = WS_LAGG + 4456448;
constexpr size_t WS_BAR = WS_LHIN + 2228224;
constexpr size_t WS_END = WS_BAR + 16384;

struct Args { const float* in[28]; float* out; unsigned char* ws; };
typedef const Args __attribute__((address_space(4)))* KArgP;
__device__ __forceinline__ KArgP kargs() { KArgP p = (KArgP)__builtin_amdgcn_kernarg_segment_ptr(); asm volatile("" : "+s"(p)); return p; }
__device__ __forceinline__ int fresh_tid() { int t = threadIdx.x; asm volatile("" : "+v"(t)); return t; }
__device__ __forceinline__ int fresh_bid() { int t = blockIdx.x; asm volatile("" : "+s"(t)); return t; }
__device__ __forceinline__ unsigned char* fresh_ws() { unsigned char* w = kargs()->ws; asm volatile("" : "+s"(w)); return w; }

__device__ __forceinline__ f32x2 mk2(float x, float y) { f32x2 r; r.x = x; r.y = y; return r; }
__device__ __forceinline__ unsigned cvt_pk_bf16(float lo, float hi) { unsigned r; asm("v_cvt_pk_bf16_f32 %0, %1, %2" : "=v"(r) : "v"(lo), "v"(hi)); return r; }
__device__ __forceinline__ float bf_lo(unsigned w) { return __uint_as_float(w << 16); }
__device__ __forceinline__ float bf_hi(unsigned w) { return __uint_as_float(w & 0xffff0000u); }
__device__ __forceinline__ float sigmoidf_(float x) { return __frcp_rn(1.0f + __expf(-x)); }
__device__ __forceinline__ float gelu_tanh(float x) { const float u = 1.5957691216057308f * (x + 0.044715f * x * x * x); return x * __frcp_rn(1.0f + __expf(-u)); }
__device__ __forceinline__ float siluf_(float x) { return x * __frcp_rn(1.0f + __expf(-x)); }

constexpr int BM = 256, BK = 64, HALF = 128, HTB = HALF * BK * 2, NXCD = 8, WGM = 8;
__device__ __forceinline__ int lds_byte(int r, int c) { const int st = (r >> 4) * 2 + (c >> 5), rr = r & 15, cc = c & 31, ob = rr * 64 + cc * 2; return st * 1024 + (ob ^ (((ob >> 9) & 1) << 5)); }
__device__ __forceinline__ void stage_rc(int b, int& R, int& C) { const int st = b / 1024, sb = b % 1024, swz = sb ^ (((sb >> 9) & 1) << 5); R = (st >> 1) * 16 + swz / 64; C = (st & 1) * 32 + (swz % 64) / 2; }
__device__ __forceinline__ int perm32(int rho) { const int n = rho >> 4, i = rho & 15; return 8 * (i >> 2) + 4 * n + (i & 3); }

struct Unit { const char* A; const char* B; int pm, pn, g; };

struct PlainOrder {
    const char* A; const char* B; size_t tA, tB; int nM, nN, nwg, G, c;
    __device__ void init(const void* A_, int lda, const void* B_, int ldb, int M, int N, int G_, int c_) {
        A = (const char*)A_; B = (const char*)B_; tA = (size_t)BM * lda * 2; tB = (size_t)BM * ldb * 2; nM = M / BM; nN = N / BM; nwg = nM * nN; G = G_; c = c_; }
    __device__ __forceinline__ bool next(int i, Unit& u) const {
        const long L = (long)i * G + c; if (L >= nwg) return false;
        int wgid = (int)L; { const int q = nwg / NXCD, r = nwg % NXCD, xcd = wgid % NXCD, off = wgid / NXCD; wgid = (xcd < r ? xcd * (q + 1) : r * (q + 1) + (xcd - r) * q) + off; }
        const int nig = WGM * nN, gid = wgid / nig, fm = gid * WGM, gsz = (nM - fm) < WGM ? (nM - fm) : WGM;
        u.pm = fm + ((wgid % nig) % gsz); u.pn = (wgid % nig) / gsz; u.g = 0;
        u.A = A + (size_t)u.pm * tA; u.B = B + (size_t)u.pn * tB; return true;
    }
};
struct BatchOrder {
    const char* A; const char* B; size_t tA, tB, gA, gB; int nM, nN, total, G, c;
    __device__ void init(const void* A_, int lda, size_t gA_, const void* B_, int ldb, size_t gB_, int nM_, int nN_, int ng, int G_, int c_) {
        A = (const char*)A_; B = (const char*)B_; tA = (size_t)BM * lda * 2; tB = (size_t)BM * ldb * 2; gA = gA_; gB = gB_; nM = nM_; nN = nN_; total = nM_ * nN_ * ng; G = G_; c = c_; }
    __device__ __forceinline__ bool next(int i, Unit& u) const {
        const long L = (long)i * G + c; if (L >= total) return false;
        const int per = nM * nN, g = (int)L / per, r = (int)L % per; u.g = g; u.pn = r / nM; u.pm = r % nM;
        u.A = A + (size_t)g * gA + (size_t)u.pm * tA; u.B = B + (size_t)g * gB + (size_t)u.pn * tB; return true;
    }
};

template <class Epi, class Sched>
__device__ __forceinline__ void gemm_phase(LAS unsigned char* lds, const int lda, const int ldb, const int K, const Sched& S, const Epi& E) {
    int tid_ = threadIdx.x; asm volatile("" : "+v"(tid_));
    const int tid = tid_, wid = __builtin_amdgcn_readfirstlane(tid >> 6), lane = tid & 63, wr = wid >> 2, wc = wid & 3, fr = lane & 15, fq = lane >> 4;
    const int nt = K / BK;
    unsigned voffA[2], voffB[2];
#pragma unroll
    for (int i = 0; i < 2; ++i) { int R, C; stage_rc(tid * 16 + i * 8192, R, C); const int Rb = Epi::PERM ? ((R & ~31) + perm32(R & 31)) : R;
        voffA[i] = (unsigned)(R * lda + C) * 2u; voffB[i] = (unsigned)(Rb * ldb + C) * 2u; }
    const size_t kstep = (size_t)(BK * 2);
    const size_t hstepA = (size_t)HALF * lda * 2, hstepB = (size_t)HALF * ldb * 2;
    const unsigned ldsw = (unsigned)wid * 1024u;
    const int aoff = lds_byte(wr * 64 + fr, fq * 8), boff = lds_byte(wc * 32 + fr, fq * 8);
#define PG8_SA(b, h) (((b) * 2 + (h)) * HTB)
#define PG8_SB(b, h) ((4 + (b) * 2 + (h)) * HTB)
#define PG8_STAGE(bufoff, gbase, voff) do { _Pragma("unroll") for (int _i = 0; _i < 2; ++_i) \
        __builtin_amdgcn_global_load_lds((const unsigned*)((const char*)(gbase) + (voff)[_i]), (LAS unsigned*)(lds + (bufoff) + ldsw + _i * 8192), 16, 0, 0); } while (0)
#define PG8_LDA(dst, b, h) do { _Pragma("unroll") for (int m = 0; m < 4; ++m) _Pragma("unroll") for (int k = 0; k < 2; ++k) dst[m][k] = *(const LAS bf16x8*)(lds + PG8_SA(b, h) + aoff + m * 2048 + k * 1024); } while (0)
#define PG8_LDB(dst, b, h) do { _Pragma("unroll") for (int n = 0; n < 2; ++n) _Pragma("unroll") for (int k = 0; k < 2; ++k) dst[n][k] = *(const LAS bf16x8*)(lds + PG8_SB(b, h) + boff + n * 2048 + k * 1024); } while (0)
#define PG8_MMA(ai, bj, At, Bt) do { __builtin_amdgcn_s_setprio(1); _Pragma("unroll") for (int m = 0; m < 4; ++m) _Pragma("unroll") for (int n = 0; n < 2; ++n) _Pragma("unroll") for (int k = 0; k < 2; ++k) \
        acc[ai][bj][m][n] = __builtin_amdgcn_mfma_f32_16x16x32_bf16(Bt[n][k], At[m][k], acc[ai][bj][m][n], 0, 0, 0); __builtin_amdgcn_s_setprio(0); } while (0)
#define PG8_WAIT_V(n) asm volatile("s_waitcnt vmcnt(" #n ")" ::: "memory")
#define PG8_WAIT_L(n) asm volatile("s_waitcnt lgkmcnt(" #n ")" ::: "memory")
#define PG8_BAR __builtin_amdgcn_s_barrier()
#define PG8_SCHED __builtin_amdgcn_sched_barrier(0)
    Unit cur, nxt; int ui = 0;
    if (!S.next(0, cur)) return;
    f32x4 acc[2][2][4][2];
#pragma unroll
    for (int a = 0; a < 2; ++a)
#pragma unroll
        for (int b = 0; b < 2; ++b)
#pragma unroll
            for (int m = 0; m < 4; ++m)
#pragma unroll
                for (int n = 0; n < 2; ++n) acc[a][b][m][n] = (f32x4){0.f, 0.f, 0.f, 0.f};
    bf16x8 At[4][2], B0[2][2], B1[2][2];
    const char* cA = cur.A; const char* cB = cur.B;
    PG8_STAGE(PG8_SB(0, 0), cB, voffB); PG8_STAGE(PG8_SA(0, 0), cA, voffA); PG8_STAGE(PG8_SB(0, 1), cB + hstepB, voffB); PG8_STAGE(PG8_SA(0, 1), cA + hstepA, voffA);
    if (wr == 1) PG8_BAR;
    PG8_WAIT_V(4); PG8_BAR;
    PG8_STAGE(PG8_SB(1, 0), cB + kstep, voffB); PG8_STAGE(PG8_SA(1, 0), cA + kstep, voffA); PG8_STAGE(PG8_SB(1, 1), cB + hstepB + kstep, voffB);
    PG8_WAIT_V(6); PG8_BAR;
    for (;;) {
        const bool has_next = S.next(ui + 1, nxt);
        const char* nA = has_next ? nxt.A : cA; const char* nB = has_next ? nxt.B : cB;
        for (int t = 0; t < nt; t += 2) {
            const bool last = (t == nt - 2);
            const char* a1 = cA + (size_t)(t + 1) * kstep;
            const char* a2 = last ? nA : cA + (size_t)(t + 2) * kstep; const char* b2 = last ? nB : cB + (size_t)(t + 2) * kstep;
            const char* a3 = a2 + kstep; const char* b3 = b2 + kstep;
            PG8_LDB(B0, 0, 0); PG8_SCHED; PG8_LDA(At, 0, 0); PG8_STAGE(PG8_SA(1, 1), a1 + hstepA, voffA);
            PG8_WAIT_L(8); PG8_BAR; PG8_WAIT_L(0); PG8_MMA(0, 0, At, B0); PG8_BAR; PG8_SCHED;
            PG8_LDB(B1, 0, 1); PG8_STAGE(PG8_SB(0, 0), b2, voffB);
            PG8_BAR; PG8_WAIT_L(0); PG8_MMA(0, 1, At, B1); PG8_BAR;
            PG8_LDA(At, 0, 1); PG8_STAGE(PG8_SA(0, 0), a2, voffA);
            PG8_BAR; PG8_WAIT_L(0); PG8_MMA(1, 0, At, B0); PG8_BAR; PG8_SCHED;
            PG8_STAGE(PG8_SB(0, 1), b2 + hstepB, voffB);
            PG8_WAIT_V(6); PG8_BAR; PG8_MMA(1, 1, At, B1); PG8_BAR;
            PG8_LDB(B0, 1, 0); PG8_SCHED; PG8_LDA(At, 1, 0); PG8_STAGE(PG8_SA(0, 1), a2 + hstepA, voffA);
            PG8_WAIT_L(8); PG8_BAR; PG8_WAIT_L(0); PG8_MMA(0, 0, At, B0); PG8_BAR; PG8_SCHED;
            PG8_LDB(B1, 1, 1); PG8_STAGE(PG8_SB(1, 0), b3, voffB);
            PG8_BAR; PG8_WAIT_L(0); PG8_MMA(0, 1, At, B1); PG8_BAR;
            PG8_LDA(At, 1, 1); PG8_STAGE(PG8_SA(1, 0), a3, voffA);
            PG8_BAR; PG8_WAIT_L(0); PG8_MMA(1, 0, At, B0); PG8_BAR; PG8_SCHED;
            PG8_STAGE(PG8_SB(1, 1), b3 + hstepB, voffB);
            PG8_WAIT_V(6); PG8_BAR; PG8_MMA(1, 1, At, B1); PG8_BAR;
        }
        E(acc, cur, wr, wc, fr, fq);
        if (!has_next) break;
#pragma unroll
        for (int a = 0; a < 2; ++a)
#pragma unroll
            for (int b = 0; b < 2; ++b)
#pragma unroll
                for (int m = 0; m < 4; ++m)
#pragma unroll
                    for (int n = 0; n < 2; ++n) acc[a][b][m][n] = (f32x4){0.f, 0.f, 0.f, 0.f};
        cur = nxt; cA = nA; cB = nB; ++ui;
    }
    PG8_WAIT_V(0);
    if (wr == 0) PG8_BAR;
    PG8_BAR;
#undef PG8_SA
#undef PG8_SB
#undef PG8_STAGE
#undef PG8_LDA
#undef PG8_LDB
#undef PG8_MMA
#undef PG8_WAIT_V
#undef PG8_WAIT_L
#undef PG8_BAR
#undef PG8_SCHED
}

typedef f32x4 AccT[2][2][4][2];

struct EpiIn {
    static constexpr bool PERM = true;
    bf16_t* us5; bf16_t* xg;
    __device__ __forceinline__ void operator()(const AccT& acc, const Unit& u, int wr, int wc, int fr, int fq) const {
#pragma unroll
        for (int ai = 0; ai < 2; ++ai)
#pragma unroll
            for (int m = 0; m < 4; ++m) {
                const int row = u.pm * BM + ai * HALF + wr * 64 + m * 16 + fr;
#pragma unroll
                for (int bj = 0; bj < 2; ++bj) {
                    const int col0 = u.pn * BM + bj * HALF + wc * 32 + 8 * fq;
                    const f32x4 v0 = acc[ai][bj][m][0], v1 = acc[ai][bj][m][1];
                    u32x4 w; w.x = cvt_pk_bf16(v0[0], v0[1]); w.y = cvt_pk_bf16(v0[2], v0[3]); w.z = cvt_pk_bf16(v1[0], v1[1]); w.w = cvt_pk_bf16(v1[2], v1[3]);
                    if (u.pn < 2) { const int g = col0 >> 4, p0 = col0 & 15, mr = row >> 5, s = row & 31;
                        *(u32x4*)(us5 + ((size_t)g * MSP + mr) * K3 + s * 16 + p0) = w; }
                    else *(u32x4*)(xg + (size_t)row * 1024 + (col0 - 512)) = w;
                }
            }
    }
};
struct EpiHloc {
    static constexpr bool PERM = false;
    float* hloc;
    __device__ __forceinline__ void operator()(const AccT& acc, const Unit& u, int wr, int wc, int fr, int fq) const {
#pragma unroll
        for (int ai = 0; ai < 2; ++ai)
#pragma unroll
            for (int m = 0; m < 4; ++m) {
                const int row = u.pm * BM + ai * HALF + wr * 64 + m * 16 + fr;
                if (row < MS) {
                    float* rp = hloc + ((size_t)u.g * MS + row) * 256 + wc * 32 + 4 * fq;
#pragma unroll
                    for (int bj = 0; bj < 2; ++bj)
#pragma unroll
                        for (int n = 0; n < 2; ++n) *(f32x4*)(rp + bj * HALF + n * 16) = acc[ai][bj][m][n];
                }
            }
    }
};
struct EpiY1 {
    static constexpr bool PERM = true;
    bf16_t* y1;
    __device__ __forceinline__ void operator()(const AccT& acc, const Unit& u, int wr, int wc, int fr, int fq) const {
#pragma unroll
        for (int ai = 0; ai < 2; ++ai)
#pragma unroll
            for (int m = 0; m < 4; ++m) {
                const int row = u.pm * BM + ai * HALF + wr * 64 + m * 16 + fr;
                if (row < MS) {
#pragma unroll
                    for (int bj = 0; bj < 2; ++bj) {
                        const int col0 = u.pn * BM + bj * HALF + wc * 32 + 8 * fq, t = col0 >> 4, q0 = col0 & 15;
                        const f32x4 v0 = acc[ai][bj][m][0], v1 = acc[ai][bj][m][1];
                        u32x4 w; w.x = cvt_pk_bf16(gelu_tanh(v0[0]), gelu_tanh(v0[1])); w.y = cvt_pk_bf16(gelu_tanh(v0[2]), gelu_tanh(v0[3]));
                        w.z = cvt_pk_bf16(gelu_tanh(v1[0]), gelu_tanh(v1[1])); w.w = cvt_pk_bf16(gelu_tanh(v1[2]), gelu_tanh(v1[3]));
                        *(u32x4*)(y1 + ((size_t)row * TS + t) * 512 + u.g * 16 + q0) = w;
                    }
                }
            }
    }
};
struct EpiGlu {
    static constexpr bool PERM = true;
    const bf16_t* y1; bf16_t* y; const float* bias;
    __device__ __forceinline__ void operator()(const AccT& acc, const Unit& u, int wr, int wc, int fr, int fq) const {
#pragma unroll
        for (int bj = 0; bj < 2; ++bj) {
            const int col0 = u.pn * BM + bj * HALF + wc * 32 + 8 * fq;
            const f32x4 b0 = *(const f32x4*)(bias + col0), b1 = *(const f32x4*)(bias + col0 + 4);
#pragma unroll
            for (int ai = 0; ai < 2; ++ai)
#pragma unroll
                for (int m = 0; m < 4; ++m) {
                    const int row = u.pm * BM + ai * HALF + wr * 64 + m * 16 + fr;
                    const u32x4 yv = *(const u32x4*)(y1 + (size_t)row * 512 + col0);
                    const f32x4 v0 = acc[ai][bj][m][0] + b0, v1 = acc[ai][bj][m][1] + b1;
                    u32x4 w;
                    w.x = cvt_pk_bf16(bf_lo(yv.x) * sigmoidf_(v0[0]), bf_hi(yv.x) * sigmoidf_(v0[1]));
                    w.y = cvt_pk_bf16(bf_lo(yv.y) * sigmoidf_(v0[2]), bf_hi(yv.y) * sigmoidf_(v0[3]));
                    w.z = cvt_pk_bf16(bf_lo(yv.z) * sigmoidf_(v1[0]), bf_hi(yv.z) * sigmoidf_(v1[1]));
                    w.w = cvt_pk_bf16(bf_lo(yv.w) * sigmoidf_(v1[2]), bf_hi(yv.w) * sigmoidf_(v1[3]));
                    *(u32x4*)(y + (size_t)row * 1024 + col0) = w;
                }
        }
    }
};
struct EpiOut {
    static constexpr bool PERM = true;
    bf16_t* o; float* rowss;
    __device__ __forceinline__ void operator()(const AccT& acc, const Unit& u, int wr, int wc, int fr, int fq) const {
#pragma unroll
        for (int ai = 0; ai < 2; ++ai)
#pragma unroll
            for (int m = 0; m < 4; ++m) {
                const int row = u.pm * BM + ai * HALF + wr * 64 + m * 16 + fr;
                float s = 0.f;
#pragma unroll
                for (int bj = 0; bj < 2; ++bj) {
                    const int col0 = u.pn * BM + bj * HALF + wc * 32 + 8 * fq;
                    const f32x4 v0 = acc[ai][bj][m][0], v1 = acc[ai][bj][m][1];
                    s += (v0[0] * v0[0] + v0[1] * v0[1]) + (v0[2] * v0[2] + v0[3] * v0[3]) + (v1[0] * v1[0] + v1[1] * v1[1]) + (v1[2] * v1[2] + v1[3] * v1[3]);
                    u32x4 w; w.x = cvt_pk_bf16(v0[0], v0[1]); w.y = cvt_pk_bf16(v0[2], v0[3]); w.z = cvt_pk_bf16(v1[0], v1[1]); w.w = cvt_pk_bf16(v1[2], v1[3]);
                    *(u32x4*)(o + (size_t)row * 1024 + col0) = w;
                }
                s += __shfl_xor(s, 16); s += __shfl_xor(s, 32);
                if (fq == 0) rowss[(size_t)row * 16 + u.pn * 4 + wc] = s;
            }
    }
};
struct EpiFfn {
    static constexpr bool PERM = true;
    bf16_t* aff;
    __device__ __forceinline__ void operator()(const AccT& acc, const Unit& u, int wr, int wc, int fr, int fq) const {
#pragma unroll
        for (int ai = 0; ai < 2; ++ai)
#pragma unroll
            for (int m = 0; m < 4; ++m) {
                const int row = u.pm * BM + ai * HALF + wr * 64 + m * 16 + fr;
                const f32x4 g0 = acc[ai][0][m][0], g1 = acc[ai][0][m][1], u0 = acc[ai][1][m][0], u1 = acc[ai][1][m][1];
                u32x4 w;
                w.x = cvt_pk_bf16(siluf_(g0[0]) * u0[0], siluf_(g0[1]) * u0[1]); w.y = cvt_pk_bf16(siluf_(g0[2]) * u0[2], siluf_(g0[3]) * u0[3]);
                w.z = cvt_pk_bf16(siluf_(g1[0]) * u1[0], siluf_(g1[1]) * u1[1]); w.w = cvt_pk_bf16(siluf_(g1[2]) * u1[2], siluf_(g1[3]) * u1[3]);
                *(u32x4*)(aff + (size_t)row * DFF + u.pn * 128 + wc * 32 + 8 * fq) = w;
            }
    }
};

__device__ void phase_mod(KArgP a, unsigned char* ws, LAS unsigned char* lds) {
    const int tid = fresh_tid(), lane = tid & 63, wv = tid >> 6;
    LAS float* sc = (LAS float*)lds;
    LAS float* red = sc + 9216;
    for (int idx = tid; idx < 9216; idx += 512) { const int bb = idx >> 10, k = idx & 1023; const float v = bb < 8 ? a->in[1][bb * 1024 + k] : a->in[3][k]; sc[idx] = siluf_(v); }
    __syncthreads();
    float* mod = (float*)(ws + WS_MOD);
    for (int u = blockIdx.x; u < 384; u += gridDim.x) {
        const int l = u / 96, jg = u % 96, j = jg * 64 + lane;
        const float* w = a->in[4] + ((size_t)l * 1024 + wv * 128) * 6144 + j;
        float acc[9];
#pragma unroll
        for (int bb = 0; bb < 9; ++bb) acc[bb] = 0.f;
        for (int k0 = 0; k0 < 128; k0 += 8) {
            float wv8[8];
#pragma unroll
            for (int e = 0; e < 8; ++e) wv8[e] = w[(size_t)(k0 + e) * 6144];
#pragma unroll
            for (int e = 0; e < 8; ++e)
#pragma unroll
                for (int bb = 0; bb < 9; ++bb) acc[bb] += sc[bb * 1024 + wv * 128 + k0 + e] * wv8[e];
        }
#pragma unroll
        for (int bb = 0; bb < 9; ++bb) red[(wv * 9 + bb) * 64 + lane] = acc[bb];
        __syncthreads();
        for (int o = tid; o < 576; o += 512) { const int bb = o >> 6, ln = o & 63; float s = a->in[5][l * 6144 + jg * 64 + ln];
#pragma unroll
            for (int w8 = 0; w8 < 8; ++w8) s += red[(w8 * 9 + bb) * 64 + ln];
            mod[((size_t)l * 9 + bb) * 6144 + jg * 64 + ln] = s; }
        __syncthreads();
    }
}

__device__ __forceinline__ void transpose_tile(const float* src, int N, bf16_t* dst, int Kd, int k0, int n0, int drow0, LAS float* t) {
    const int tid = fresh_tid();
#pragma unroll
    for (int i = 0; i < 16; ++i) { const int k = i * 8 + (tid >> 6), n = tid & 63; t[k * 65 + n] = src[(size_t)(k0 + k) * N + n0 + n]; }
    __syncthreads();
#pragma unroll
    for (int i = 0; i < 8; ++i) { const int n = i * 8 + (tid >> 6), kk = (tid & 63) * 2;
        *(unsigned*)(dst + (size_t)(drow0 + n) * Kd + k0 + kk) = cvt_pk_bf16(t[kk * 65 + n], t[(kk + 1) * 65 + n]); }
    __syncthreads();
}
__device__ void phase_wconv(KArgP a, unsigned char* ws, LAS unsigned char* lds) {
    LAS float* t = (LAS float*)lds;
    for (int T = blockIdx.x; T < 4 * 1408; T += gridDim.x) {
        const int l = T / 1408; int r = T % 1408;
        unsigned char* wl = ws + WS_WL + (size_t)l * WL_SIZE;
        if (r < 192) { const int kt = r / 24, nt = r % 24; transpose_tile(a->in[7] + (size_t)l * 1024 * 1536, 1536, (bf16_t*)(wl + WL_IN), 1024, kt * 128, nt * 64, nt * 64, t); }
        else if (r < 224) { r -= 192; const int kt = r / 8, nt = r % 8; transpose_tile(a->in[16] + (size_t)l * 512 * 512, 512, (bf16_t*)(wl + WL_GLU), 512, kt * 128, nt * 64, nt * 64, t); }
        else if (r < 352) { r -= 224; const int kt = r / 16, nt = r % 16; transpose_tile(a->in[25] + (size_t)l * 1024 * 1024, 1024, (bf16_t*)(wl + WL_OUT), 1024, kt * 128, nt * 64, nt * 64, t); }
        else if (r < 1056) { r -= 352; const int kt = r / 88, nt = r % 88; const int n0 = nt * 64;
            const int drow0 = n0 < DFF ? 256 * (n0 / 128) + (n0 % 128) : 256 * ((n0 - DFF) / 128) + 128 + ((n0 - DFF) % 128);
            transpose_tile(a->in[26] + (size_t)l * 1024 * 5632, 5632, (bf16_t*)(wl + WL_FI), 1024, kt * 128, n0, drow0, t); }
        else { r -= 1056; const int kt = r / 16, nt = r % 16; transpose_tile(a->in[27] + (size_t)l * DFF * 1024, 1024, (bf16_t*)(wl + WL_FO), DFF, kt * 128, nt * 64, nt * 64, t); }
    }
    for (int idx = fresh_bid() * 512 + fresh_tid(); idx < 4 * 8 * 4 * 64 * 64; idx += gridDim.x * 512) {
        const int j = idx & 63, k = (idx >> 6) & 63, nb = (idx >> 12) & 3, h = (idx >> 14) & 7, l = idx >> 17;
        const float* src = (nb & 1) ? a->in[22] : a->in[20];
        const float v = src[((((size_t)l * 2 + (nb >> 1)) * 8 + h) * 64 + k) * 64 + j];
        bf16_t* dst = (bf16_t*)(ws + WS_WL + (size_t)l * WL_SIZE + WL_LRU);
        dst[((size_t)h * 256 + nb * 64 + j) * 64 + k] = (bf16_t)(cvt_pk_bf16(v, 0.f) & 0xffffu);
    }
}

__device__ void s5tab_group(KArgP a, unsigned char* ws, LAS unsigned char* lds, int layer, int g) {
    const int tid = fresh_tid();
    LAS f32x2* abp = (LAS f32x2*)lds;
    LAS f32x2* bbv = (LAS f32x2*)(lds + 33792);
    LAS f32x2* ccv = (LAS f32x2*)(lds + 50176);
    LAS float* kt = (LAS float*)(lds + 66560);
    if (tid < 128) {
        const int d = tid >> 6, n = tid & 63, base = (layer * 2 + d) * 32 + g;
        const float dt = expf(a->in[10][base]);
        const float are = a->in[8][base * 64 + n], aim = a->in[9][base * 64 + n];
        for (int tau = 0; tau <= 32; ++tau) {
            const float mag = expf(are * dt * (float)tau);
            float rev = aim * dt * (float)tau * 0.15915494309189535f; rev -= rintf(rev);
            const float ang = rev * 6.283185307179586f;
            abp[(d * 64 + n) * 33 + tau] = mk2(mag * cosf(ang), mag * sinf(ang));
        }
        const float zr = are * dt; float rev = aim * dt * 0.15915494309189535f; rev -= rintf(rev); const float zi = rev * 6.283185307179586f;
        const float em1 = expm1f(zr), cz = cosf(zi), sz = sinf(zi), s2 = sinf(0.5f * zi);
        const float nr = em1 * cz - 2.f * s2 * s2, abim = (em1 + 1.f) * sz;
        const float den = are * are + aim * aim;
        const float fre = (nr * are + abim * aim) / den, fim = (abim * are - nr * aim) / den;
        for (int p = 0; p < 16; ++p) {
            const float br = a->in[11][((size_t)base * 64 + n) * 16 + p], bi = a->in[12][((size_t)base * 64 + n) * 16 + p];
            bbv[(d * 64 + n) * 16 + p] = mk2(fre * br - fim * bi, fre * bi + fim * br);
        }
        for (int q = 0; q < 16; ++q) ccv[(d * 16 + q) * 64 + n] = mk2(a->in[13][((size_t)base * 16 + q) * 64 + n], a->in[14][((size_t)base * 16 + q) * 64 + n]);
        ((f32x2*)(ws + WS_AT))[(g * 2 + d) * 64 + n] = abp[(d * 64 + n) * 33 + 32];
    }
    __syncthreads();
    for (int it = 0; it < 2; ++it) {
        const int combo = tid + it * 512, d = combo >> 9, tau = (combo >> 4) & 31, q = combo & 15;
        float acc[16];
#pragma unroll
        for (int p = 0; p < 16; ++p) acc[p] = 0.f;
        for (int n = 0; n < 64; ++n) {
            const f32x2 c = ccv[(d * 16 + q) * 64 + n], pw = abp[(d * 64 + n) * 33 + tau];
            const float wr_ = c.x * pw.x - c.y * pw.y, wi_ = c.x * pw.y + c.y * pw.x;
#pragma unroll
            for (int p = 0; p < 16; ++p) { const f32x2 bv = bbv[(d * 64 + n) * 16 + p]; acc[p] += wr_ * bv.x - wi_ * bv.y; }
        }
#pragma unroll
        for (int p = 0; p < 16; ++p) kt[((d * 32 + tau) * 16 + q) * 16 + p] = acc[p];
    }
    __syncthreads();
    bf16_t* bt3 = (bf16_t*)(ws + WS_BT3) + (size_t)g * 512 * K3;
    bf16_t* bt1 = (bf16_t*)(ws + WS_BT1) + (size_t)g * 256 * K1;
    const float* dvec = a->in[15] + layer * 512 + g * 16;
    for (int i = 0; i < 64; ++i) {
        const int it = tid + 512 * i, row = it >> 6, s = (it >> 1) & 31, ph = it & 1, t = row >> 4, q = row & 15;
        float v[8];
#pragma unroll
        for (int e = 0; e < 8; ++e) { const int p = ph * 8 + e; float x = 0.f;
            if (s <= t) x += kt[(((t - s)) * 16 + q) * 16 + p];
            if (s >= t) x += kt[((32 + (s - t)) * 16 + q) * 16 + p];
            if (s == t && p == q) x += dvec[q];
            v[e] = x; }
        u32x4 w; w.x = cvt_pk_bf16(v[0], v[1]); w.y = cvt_pk_bf16(v[2], v[3]); w.z = cvt_pk_bf16(v[4], v[5]); w.w = cvt_pk_bf16(v[6], v[7]);
        *(u32x4*)(bt3 + (size_t)row * K3 + s * 16 + ph * 8) = w;
    }
    for (int i = 0; i < 32; ++i) {
        const int it = tid + 512 * i, row = it >> 5, c8 = (it & 31) * 8, t = row >> 4, q = row & 15, d = c8 >> 7, n0 = (c8 & 127) >> 1;
        const int pw = d == 0 ? t + 1 : 32 - t;
        float v[8];
#pragma unroll
        for (int e = 0; e < 4; ++e) { const f32x2 c = ccv[(d * 16 + q) * 64 + n0 + e], pa = abp[(d * 64 + n0 + e) * 33 + pw];
            v[2 * e] = c.x * pa.x - c.y * pa.y; v[2 * e + 1] = -(c.x * pa.y + c.y * pa.x); }
        u32x4 w; w.x = cvt_pk_bf16(v[0], v[1]); w.y = cvt_pk_bf16(v[2], v[3]); w.z = cvt_pk_bf16(v[4], v[5]); w.w = cvt_pk_bf16(v[6], v[7]);
        *(u32x4*)(bt3 + (size_t)row * K3 + 512 + c8) = w;
    }
    for (int i = 0; i < 32; ++i) {
        const int it = tid + 512 * i, row = it >> 6, k8 = (it & 63) * 8, s = k8 >> 4, p0 = k8 & 15, d = row >> 7, n = (row & 127) >> 1, ci = row & 1;
        const int pw = d == 0 ? 31 - s : s;
        const f32x2 pa = abp[(d * 64 + n) * 33 + pw];
        float v[8];
#pragma unroll
        for (int e = 0; e < 8; ++e) { const f32x2 bv = bbv[(d * 64 + n) * 16 + p0 + e]; v[e] = ci ? (pa.x * bv.y + pa.y * bv.x) : (pa.x * bv.x - pa.y * bv.y); }
        u32x4 w; w.x = cvt_pk_bf16(v[0], v[1]); w.y = cvt_pk_bf16(v[2], v[3]); w.z = cvt_pk_bf16(v[4], v[5]); w.w = cvt_pk_bf16(v[6], v[7]);
        *(u32x4*)(bt1 + (size_t)row * K1 + k8) = w;
    }
    __syncthreads();
}

template <int MODE>
__device__ void phase_norm(KArgP a, unsigned char* ws, int layer) {
    const int tid = fresh_tid();
    const int lane = tid & 63, wid = tid >> 6;
    const int gw = fresh_bid() * 8 + wid, GW = gridDim.x * 8;
    const float* mod = (const float*)(ws + WS_MOD);
    const float* gains = a->in[6];
    const bool from_input = (MODE == 0) || (MODE == 1 && layer == 0);
    for (int R = gw; R < MTOK; R += GW) {
        const int b = R / POS, pos = R % POS; const bool isctx = pos < CTXL; const int cb = isctx ? 8 : b;
        const float* xsrc; float* xdst;
        if (isctx) { const size_t o = ((size_t)b * CTXL + pos) * D; xdst = (float*)(ws + WS_CTXR) + o; xsrc = from_input ? a->in[2] + o : xdst; }
        else { const size_t o = ((size_t)b * SEQ + (pos - CTXL)) * D; xdst = a->out + o; xsrc = from_input ? a->in[0] + o : xdst; }
        float x[16];
#pragma unroll
        for (int i = 0; i < 2; ++i) { const int c0 = lane * 8 + 512 * i; const f32x4 p = *(const f32x4*)(xsrc + c0), q = *(const f32x4*)(xsrc + c0 + 4);
            x[8 * i + 0] = p[0]; x[8 * i + 1] = p[1]; x[8 * i + 2] = p[2]; x[8 * i + 3] = p[3]; x[8 * i + 4] = q[0]; x[8 * i + 5] = q[1]; x[8 * i + 6] = q[2]; x[8 * i + 7] = q[3]; }
        if (MODE != 0) {
            const float* rs = (const float*)(ws + WS_ROWSS) + (size_t)R * 16;
            const f32x4 r0 = *(const f32x4*)rs, r1 = *(const f32x4*)(rs + 4), r2 = *(const f32x4*)(rs + 8), r3 = *(const f32x4*)(rs + 12);
            const float ss = ((r0[0] + r0[1]) + (r0[2] + r0[3])) + ((r1[0] + r1[1]) + (r1[2] + r1[3])) + ((r2[0] + r2[1]) + (r2[2] + r2[3])) + ((r3[0] + r3[1]) + (r3[2] + r3[3]));
            const float rstd = rsqrtf(ss * (1.0f / 1024.0f) + EPS);
            const bf16_t* o = (const bf16_t*)(ws + WS_R3) + (size_t)R * D;
            const float* gate = mod + ((size_t)layer * 9 + cb) * 6144 + (MODE == 1 ? 2 : 5) * 1024;
            const float* gpost = gains + ((size_t)layer * 4 + (MODE == 1 ? 1 : 3)) * 1024;
#pragma unroll
            for (int i = 0; i < 2; ++i) { const int c0 = lane * 8 + 512 * i; const u32x4 ov = *(const u32x4*)(o + c0);
                const float of[8] = {bf_lo(ov.x), bf_hi(ov.x), bf_lo(ov.y), bf_hi(ov.y), bf_lo(ov.z), bf_hi(ov.z), bf_lo(ov.w), bf_hi(ov.w)};
                const f32x4 g0 = *(const f32x4*)(gate + c0), g1 = *(const f32x4*)(gate + c0 + 4), p0 = *(const f32x4*)(gpost + c0), p1 = *(const f32x4*)(gpost + c0 + 4);
#pragma unroll
                for (int e = 0; e < 4; ++e) { x[8 * i + e] += g0[e] * ((of[e] * rstd) * p0[e]); x[8 * i + 4 + e] += g1[e] * ((of[4 + e] * rstd) * p1[e]); }
                *(f32x4*)(xdst + c0) = (f32x4){x[8 * i], x[8 * i + 1], x[8 * i + 2], x[8 * i + 3]}; *(f32x4*)(xdst + c0 + 4) = (f32x4){x[8 * i + 4], x[8 * i + 5], x[8 * i + 6], x[8 * i + 7]}; }
        }
        if (MODE == 2 && layer == DEPTH - 1) continue;
        float s2 = 0.f;
#pragma unroll
        for (int e = 0; e < 16; ++e) s2 += x[e] * x[e];
#pragma unroll
        for (int off = 32; off >= 1; off >>= 1) s2 += __shfl_xor(s2, off);
        const float rstd2 = rsqrtf(s2 * (1.0f / 1024.0f) + EPS);
        const int ln = MODE == 2 ? layer + 1 : layer;
        const float* gpre = gains + ((size_t)ln * 4 + (MODE == 1 ? 2 : 0)) * 1024;
        const float* shp = mod + ((size_t)ln * 9 + cb) * 6144 + (MODE == 1 ? 3 : 0) * 1024;
        const float* scp = shp + 1024;
        bf16_t* h = (bf16_t*)(ws + WS_R2) + (size_t)R * D;
#pragma unroll
        for (int i = 0; i < 2; ++i) { const int c0 = lane * 8 + 512 * i; float hv[8];
            const f32x4 g0 = *(const f32x4*)(gpre + c0), g1 = *(const f32x4*)(gpre + c0 + 4), s0 = *(const f32x4*)(shp + c0), s1 = *(const f32x4*)(shp + c0 + 4), c0v = *(const f32x4*)(scp + c0), c1v = *(const f32x4*)(scp + c0 + 4);
#pragma unroll
            for (int e = 0; e < 4; ++e) { hv[e] = ((x[8 * i + e] * rstd2) * g0[e]) * (1.f + c0v[e]) + s0[e]; hv[4 + e] = ((x[8 * i + 4 + e] * rstd2) * g1[e]) * (1.f + c1v[e]) + s1[e]; }
            u32x4 w; w.x = cvt_pk_bf16(hv[0], hv[1]); w.y = cvt_pk_bf16(hv[2], hv[3]); w.z = cvt_pk_bf16(hv[4], hv[5]); w.w = cvt_pk_bf16(hv[6], hv[7]);
            *(u32x4*)(h + c0) = w; }
    }
}

__device__ __forceinline__ int lru_tok(int b, int cl, int j) {
    if (cl < 4) { const int p = cl * 64 + j; return (p >= 0 && p < CTXL) ? b * POS + p : -1; }
    const int jj = (cl - 4) * 64 + j; if (jj < 0 || jj >= SEQ) return -1;
    return b * POS + CTXL + (jj & 63) * 64 + (jj >> 6);
}
template <int MODE>
__device__ void lru_unit(KArgP a, unsigned char* ws, LAS unsigned char* lds, int layer, int b, int cl, int head) {
    const int tid = fresh_tid(), lane = tid & 63, wv = tid >> 6;
    LAS float* xr_s = (LAS float*)lds;
    LAS float* xcf = (LAS float*)(lds + 17408);
    LAS bf16_t* xcb = (LAS bf16_t*)(lds + 33792);
    LAS f32x2* ab = (LAS f32x2*)(lds + 43008);
    LAS f32x2* sagg = (LAS f32x2*)(lds + 108544);
    const bf16_t* xg = (const bf16_t*)(ws + WS_XG);
    for (int idx = tid; idx < 67 * 8; idx += 512) {
        const int pi = idx >> 3, c8 = (idx & 7) * 8, tok = lru_tok(b, cl, pi - 2);
        u32x4 v = (u32x4){0u, 0u, 0u, 0u};
        if (tok >= 0) v = *(const u32x4*)(xg + (size_t)tok * 1024 + head * 64 + c8);
        LAS float* dp = xr_s + pi * 64 + c8;
        dp[0] = bf_lo(v.x); dp[1] = bf_hi(v.x); dp[2] = bf_lo(v.y); dp[3] = bf_hi(v.y); dp[4] = bf_lo(v.z); dp[5] = bf_hi(v.z); dp[6] = bf_lo(v.w); dp[7] = bf_hi(v.w);
    }
    __syncthreads();
    {
        const int t = tid >> 3, c8 = (tid & 7) * 8;
        const float* cw = a->in[18] + (size_t)layer * 4 * 512 + head * 64 + c8;
        const float* cbias = a->in[19] + layer * 512 + head * 64 + c8;
#pragma unroll
        for (int e = 0; e < 8; ++e) {
            float v = cbias[e];
#pragma unroll
            for (int k = 0; k < 4; ++k) v += cw[k * 512 + e] * xr_s[(t + k) * 64 + c8 + e];
            xcf[t * 64 + c8 + e] = v;
            xcb[t * 72 + c8 + e] = (bf16_t)(cvt_pk_bf16(v, 0.f) & 0xffffu);
        }
    }
    __syncthreads();
    {
        const int d = wv >> 2, cb = wv & 3, fr = lane & 15, fq = lane >> 4;
        const bf16_t* Wl = (const bf16_t*)(ws + WS_WL + (size_t)layer * WL_SIZE + WL_LRU) + (size_t)head * 256 * 64;
        bf16x8 Bf[2][2], Af[4][2];
#pragma unroll
        for (int gt = 0; gt < 2; ++gt)
#pragma unroll
            for (int ks = 0; ks < 2; ++ks) Bf[gt][ks] = *(const bf16x8*)(Wl + (size_t)((d * 2 + gt) * 64 + cb * 16 + fr) * 64 + ks * 32 + fq * 8);
#pragma unroll
        for (int m = 0; m < 4; ++m)
#pragma unroll
            for (int ks = 0; ks < 2; ++ks) Af[m][ks] = *(const LAS bf16x8*)(xcb + (16 * m + fr) * 72 + ks * 32 + fq * 8);
        f32x4 acc[2][4];
#pragma unroll
        for (int gt = 0; gt < 2; ++gt)
#pragma unroll
            for (int m = 0; m < 4; ++m) { acc[gt][m] = (f32x4){0.f, 0.f, 0.f, 0.f};
#pragma unroll
                for (int ks = 0; ks < 2; ++ks) acc[gt][m] = __builtin_amdgcn_mfma_f32_16x16x32_bf16(Af[m][ks], Bf[gt][ks], acc[gt][m], 0, 0, 0); }
        const int ch = cb * 16 + fr, hc = head * 64 + ch, pidx = (layer * 2 + d) * 512 + hc;
        const float brg = a->in[21][pidx], big = a->in[23][pidx], lam = a->in[24][pidx];
        const float ex = __expf(-lam);
        const float sp = ex < 0.1f ? ex * (1.f - ex * (0.5f - ex * (0.33333333f - ex * 0.25f))) : __logf(1.f + ex);
#pragma unroll
        for (int m = 0; m < 4; ++m)
#pragma unroll
            for (int rg = 0; rg < 4; ++rg) {
                const int t = 16 * m + 4 * fq + rg;
                const float r = sigmoidf_(acc[0][m][rg] + brg), ig = sigmoidf_(acc[1][m][rg] + big);
                const float la = -8.0f * r * sp, av = __expf(la), z = 2.f * la;
                const float om = z > -0.3f ? -z * (1.f + 0.5f * z * (1.f + 0.33333333f * z * (1.f + 0.25f * z * (1.f + 0.2f * z * (1.f + 0.16666667f * z))))) : 1.f - __expf(z);
                const float bv = sqrtf(om) * ig * xcf[t * 64 + ch];
                ab[(d * 64 + t) * 64 + ch] = mk2(av, bv);
            }
    }
    __syncthreads();
    const int seg = tid >> 7, d2 = (tid >> 6) & 1, ch2 = tid & 63;
    {
        float A = 1.f, H = 0.f;
#pragma unroll
        for (int q = 0; q < 16; ++q) { const int t = seg * 16 + (d2 ? 15 - q : q); const f32x2 v = ab[(d2 * 64 + t) * 64 + ch2]; H = v.x * H + v.y; A *= v.x; }
        sagg[(seg * 2 + d2) * 64 + ch2] = mk2(A, H);
    }
    __syncthreads();
    const size_t gidx = ((size_t)(b * LCH + cl) * 2 + d2) * 512 + head * 64 + ch2;
    if (MODE == 0) {
        if (seg == 0) {
            float A = 1.f, H = 0.f;
#pragma unroll
            for (int s = 0; s < 4; ++s) { const f32x2 v = sagg[((d2 ? 3 - s : s) * 2 + d2) * 64 + ch2]; H = v.x * H + v.y; A *= v.x; }
            ((f32x2*)(ws + WS_LAGG))[gidx] = mk2(A, H);
        }
    } else {
        float H = ((const float*)(ws + WS_LHIN))[gidx];
        if (d2 == 0) { for (int s = 0; s < seg; ++s) { const f32x2 v = sagg[(s * 2) * 64 + ch2]; H = v.x * H + v.y; } }
        else { for (int s = 3; s > seg; --s) { const f32x2 v = sagg[(s * 2 + 1) * 64 + ch2]; H = v.x * H + v.y; } }
#pragma unroll
        for (int q = 0; q < 16; ++q) { const int t = seg * 16 + (d2 ? 15 - q : q); const f32x2 v = ab[(d2 * 64 + t) * 64 + ch2]; H = v.x * H + v.y; ab[(d2 * 64 + t) * 64 + ch2].y = H; }
        __syncthreads();
        const int t = tid >> 3, c8 = (tid & 7) * 8, tok = lru_tok(b, cl, t);
        const u32x4 gv = *(const u32x4*)(xg + (size_t)tok * 1024 + 512 + head * 64 + c8);
        const float gr[8] = {bf_lo(gv.x), bf_hi(gv.x), bf_lo(gv.y), bf_hi(gv.y), bf_lo(gv.z), bf_hi(gv.z), bf_lo(gv.w), bf_hi(gv.w)};
        float o[8];
#pragma unroll
        for (int e = 0; e < 8; ++e) o[e] = (ab[t * 64 + c8 + e].y + ab[(64 + t) * 64 + c8 + e].y) * gelu_tanh(gr[e]);
        u32x4 w; w.x = cvt_pk_bf16(o[0], o[1]); w.y = cvt_pk_bf16(o[2], o[3]); w.z = cvt_pk_bf16(o[4], o[5]); w.w = cvt_pk_bf16(o[6], o[7]);
        *(u32x4*)((bf16_t*)(ws + WS_R2) + (size_t)tok * 1024 + 512 + head * 64 + c8) = w;
    }
    __syncthreads();
}
template <int MODE>
__device__ void phase_lru(KArgP a, unsigned char* ws, LAS unsigned char* lds, int layer) {
    for (int U = (int)(gridDim.x - 1 - fresh_bid()); U < NB * LCH * NH; U += gridDim.x) {
        const int head = U & 7, bc = U >> 3; lru_unit<MODE>(a, ws, lds, layer, bc / LCH, bc % LCH, head);
    }
}

__device__ void phase_carry(unsigned char* ws) {
    const int tid = fresh_tid(), bid = fresh_bid();
    const int lane = tid & 63, wid = tid >> 6;
    for (int item = wid * gridDim.x + bid; item < 640; item += 8 * gridDim.x) {
        if (item < 512) {
            const int g = item >> 4, b = (item >> 1) & 7, d = item & 1, n = lane;
            const f32x2 aT = ((const f32x2*)(ws + WS_AT))[(g * 2 + d) * 64 + n];
            const f32x2* hl = (const f32x2*)(ws + WS_HLOC) + ((size_t)(g * MS + b * SCH) * 256 + d * 128 + 2 * n) / 2;
            unsigned* hin = (unsigned*)(ws + WS_US5) + ((size_t)(g * MSP + b * SCH) * K3 + 512 + d * 128 + 2 * n) / 2;
            float hr = 0.f, hi = 0.f;
            for (int ib = 0; ib < SCH / 8; ++ib) {
                f32x2 L[8];
#pragma unroll
                for (int e = 0; e < 8; ++e) { const int i = ib * 8 + e, c = d == 0 ? i : (i < 8 ? 7 - i : 143 - i); L[e] = hl[(size_t)c * 128]; }
#pragma unroll
                for (int e = 0; e < 8; ++e) { const int i = ib * 8 + e, c = d == 0 ? i : (i < 8 ? 7 - i : 143 - i);
                    hin[(size_t)c * (K3 / 2)] = cvt_pk_bf16(hr, hi);
                    const float nr = aT.x * hr - aT.y * hi + L[e].x, ni = aT.x * hi + aT.y * hr + L[e].y; hr = nr; hi = ni; }
            }
        } else {
            const int tl = (item - 512) * 64 + lane, b = tl >> 10, d = (tl >> 9) & 1, ch = tl & 511;
            const f32x2* ag = (const f32x2*)(ws + WS_LAGG) + ((size_t)b * LCH * 2 + d) * 512 + ch;
            float* hin = (float*)(ws + WS_LHIN) + ((size_t)b * LCH * 2 + d) * 512 + ch;
            float H = 0.f;
            for (int ib = 0; ib < LCH / 4; ++ib) {
                f32x2 L[4];
#pragma unroll
                for (int e = 0; e < 4; ++e) { const int i = ib * 4 + e, cl = d == 0 ? i : (i < 4 ? 3 - i : 71 - i); L[e] = ag[(size_t)cl * 1024]; }
#pragma unroll
                for (int e = 0; e < 4; ++e) { const int i = ib * 4 + e, cl = d == 0 ? i : (i < 4 ? 3 - i : 71 - i); hin[(size_t)cl * 1024] = H; H = L[e].x * H + L[e].y; }
            }
        }
    }
}

#define XB_TMO      128
#define XB_XCNT(j)  (256  + 64 * (j))
#define XB_XSUB(j)  (1280 + 64 * (j))
#define XB_XGEN(j)  (2304 + 64 * (j))
#define XB_TOP      3328
#define XB_TOPGEN   3392
#define XCD_BAR_WORDS 3456
#define XB_SPIN_CAP (1u << 22)
__device__ __forceinline__ unsigned xb_ld(unsigned* p)              { return __hip_atomic_load(p, __ATOMIC_RELAXED, __HIP_MEMORY_SCOPE_AGENT); }
__device__ __forceinline__ unsigned xb_add(unsigned* p, unsigned v) { return __hip_atomic_fetch_add(p, v, __ATOMIC_RELAXED, __HIP_MEMORY_SCOPE_AGENT); }
__device__ __forceinline__ unsigned xb_xcc_id() { return (unsigned)__builtin_amdgcn_s_getreg((3 << 11) | 20) & 0xFu; }
#define XB_SPIN(cond, bar) do { unsigned _sp = 0; while (cond) { __builtin_amdgcn_s_sleep(1); \
    if ((++_sp & 255u) == 0u) { if (xb_ld(&(bar)[XB_TMO])) break; if (_sp > XB_SPIN_CAP) { atomicAdd(&(bar)[XB_TMO], 1u); break; } } } } while (0)
__device__ __forceinline__ void xcd_barrier_complete(unsigned* bar, unsigned x, unsigned& nloc, unsigned& nx) {
    const unsigned G = gridDim.x * gridDim.y * gridDim.z;
    unsigned sum, cnt, mine, sp = 0u;
    for (;;) {
        sum = 0u; cnt = 0u; mine = 0u;
#pragma unroll
        for (unsigned j = 0; j < 16; ++j) { const unsigned c = xb_ld(&bar[XB_XCNT(j)]); sum += c; cnt += (c > 0u) ? 1u : 0u; mine = (j == x) ? c : mine; }
        if (sum == G) break;
        __builtin_amdgcn_s_sleep(1);
        if ((++sp & 255u) == 0u) { if (xb_ld(&bar[XB_TMO])) break; if (sp > XB_SPIN_CAP) { atomicAdd(&bar[XB_TMO], 1u); break; } }
    }
    nloc = mine > 0u ? mine : 1u; nx = cnt > 0u ? cnt : 1u;
}
__device__ __forceinline__ void xcd_barrier(unsigned* bar, volatile LAS unsigned* st) {
    asm volatile("s_waitcnt vmcnt(0)" ::: "memory");
    __syncthreads();
    if (threadIdx.x == 0) {
        const unsigned x = xb_xcc_id();
        __builtin_amdgcn_s_waitcnt(0);
        unsigned nloc = st[0], nx = st[1];
        if (nloc == 0u) { xcd_barrier_complete(bar, x, nloc, nx); st[0] = nloc; st[1] = nx; }
        const unsigned old = xb_add(&bar[XB_XSUB(x)], 1u);
        const unsigned gen = old / nloc;
        if (old + 1u == (gen + 1u) * nloc) {
            __builtin_amdgcn_fence(__ATOMIC_RELEASE, "agent");
            asm volatile("s_waitcnt vmcnt(0)" ::: "memory");
            const unsigned og = xb_add(&bar[XB_TOP], 1u);
            const unsigned tg = og / nx;
            if (og + 1u == (tg + 1u) * nx) xb_add(&bar[XB_TOPGEN], 1u);
            else XB_SPIN(xb_ld(&bar[XB_TOPGEN]) == tg, bar);
            __builtin_amdgcn_fence(__ATOMIC_ACQUIRE, "agent");
            xb_add(&bar[XB_XGEN(x)], 1u);
            asm volatile("s_waitcnt vmcnt(0)" ::: "memory");
        } else {
            XB_SPIN(xb_ld(&bar[XB_XGEN(x)]) == gen, bar);
            __builtin_amdgcn_fence(__ATOMIC_ACQUIRE, "agent");
            asm volatile("s_waitcnt vmcnt(0)" ::: "memory");
        }
    }
    __syncthreads();
}

__global__ void __launch_bounds__(512, 2) mega(Args a_unused) {
    extern __shared__ __attribute__((aligned(16))) unsigned char lds_raw[];
    LAS unsigned char* lds = (LAS unsigned char*)lds_raw;
    cg::grid_group grid = cg::this_grid();
    const int G = gridDim.x, c = blockIdx.x;
    volatile LAS unsigned* bst = (volatile LAS unsigned*)(lds + (LDS_BYTES - 16));
    unsigned* const gbar = (unsigned*)(kargs()->ws + WS_BAR);
    if (threadIdx.x == 0) { bst[0] = 0u; bst[1] = 0u; (void)xb_add(&gbar[XB_XCNT(xb_xcc_id())], 1u); }
    __syncthreads();
#define GSYNC() xcd_barrier(gbar, bst)
#define PH_BEGIN KArgP a = kargs(); unsigned char* ws = fresh_ws(); (void)a; (void)ws;

#if PM & 1
    for (int rep = 0; rep < REP_P0; ++rep) {
    { PH_BEGIN for (int g = c; g < NG; g += G) s5tab_group(a, ws, lds, 0, g); }
#endif
#if PM & 2
    { PH_BEGIN phase_mod(a, ws, lds); }
#endif
#if PM & 4
    { PH_BEGIN phase_wconv(a, ws, lds); }
#endif
    }
    grid.sync();
#if PM & 8
    { PH_BEGIN phase_norm<0>(a, ws, 0); }
#endif
    GSYNC();

#pragma unroll 1
    for (int l = 0; l < DEPTH; ++l) {
#if PM & 16
        for (int rep = 0; rep < REP_GEMM; ++rep) { PH_BEGIN unsigned char* wl = ws + WS_WL + (size_t)l * WL_SIZE;
          PlainOrder S; S.init(ws + WS_R2, 1024, wl + WL_IN, 1024, MTOK, DIN, G, c); EpiIn E{(bf16_t*)(ws + WS_US5), (bf16_t*)(ws + WS_XG)};
          gemm_phase<EpiIn, PlainOrder>(lds, 1024, 1024, 1024, S, E); }
#endif
        GSYNC();
#if PM & 32
        for (int rep = 0; rep < REP_GEMM; ++rep) { PH_BEGIN BatchOrder S; S.init(ws + WS_US5, K3, (size_t)MSP * K3 * 2, ws + WS_BT1, K1, (size_t)256 * K1 * 2, MSP / BM, 1, NG, G, c); EpiHloc E{(float*)(ws + WS_HLOC)};
          gemm_phase<EpiHloc, BatchOrder>(lds, K3, K1, K1, S, E); }
#endif
#if PM & 2048
        for (int rep = 0; rep < REP_LRU; ++rep) { PH_BEGIN phase_lru<0>(a, ws, lds, l); }
#endif
        GSYNC();
#if PM & 8192
        for (int rep = 0; rep < REP_CARRY; ++rep) { PH_BEGIN phase_carry(ws); }
#endif
        GSYNC();
#if PM & 64
        for (int rep = 0; rep < REP_GEMM; ++rep) { PH_BEGIN BatchOrder S; S.init(ws + WS_US5, K3, (size_t)MSP * K3 * 2, ws + WS_BT3, K3, (size_t)512 * K3 * 2, MSP / BM, 2, NG, G, c); EpiY1 E{(bf16_t*)(ws + WS_Y1)};
          gemm_phase<EpiY1, BatchOrder>(lds, K3, K3, K3, S, E); }
#endif
#if PM & 4096
        for (int rep = 0; rep < REP_LRU; ++rep) { PH_BEGIN phase_lru<1>(a, ws, lds, l); }
#endif
        GSYNC();
#if PM & 128
        for (int rep = 0; rep < REP_GEMM; ++rep) { PH_BEGIN unsigned char* wl = ws + WS_WL + (size_t)l * WL_SIZE;
          PlainOrder S; S.init(ws + WS_Y1, 512, wl + WL_GLU, 512, MTOK, 512, G, c); EpiGlu E{(const bf16_t*)(ws + WS_Y1), (bf16_t*)(ws + WS_R2), a->in[17] + l * 512};
          gemm_phase<EpiGlu, PlainOrder>(lds, 512, 512, 512, S, E); }
#endif
        GSYNC();
#if PM & 256
        for (int rep = 0; rep < REP_GEMM; ++rep) { PH_BEGIN unsigned char* wl = ws + WS_WL + (size_t)l * WL_SIZE;
          PlainOrder S; S.init(ws + WS_R2, 1024, wl + WL_OUT, 1024, MTOK, 1024, G, c); EpiOut E{(bf16_t*)(ws + WS_R3), (float*)(ws + WS_ROWSS)};
          gemm_phase<EpiOut, PlainOrder>(lds, 1024, 1024, 1024, S, E); }
#endif
        GSYNC();
#if PM & 1
        { PH_BEGIN if (l + 1 < DEPTH) for (int g = c; g < NG; g += G) s5tab_group(a, ws, lds, l + 1, g); }
#endif
#if PM & 16384
        { PH_BEGIN phase_norm<1>(a, ws, l); }
#endif
        GSYNC();
#if PM & 512
        for (int rep = 0; rep < REP_GEMM; ++rep) { PH_BEGIN unsigned char* wl = ws + WS_WL + (size_t)l * WL_SIZE;
          PlainOrder S; S.init(ws + WS_R2, 1024, wl + WL_FI, 1024, MTOK, 2 * DFF, G, c); EpiFfn E{(bf16_t*)(ws + WS_AFF)};
          gemm_phase<EpiFfn, PlainOrder>(lds, 1024, 1024, 1024, S, E); }
#endif
        GSYNC();
#if PM & 1024
        for (int rep = 0; rep < REP_GEMM; ++rep) { PH_BEGIN unsigned char* wl = ws + WS_WL + (size_t)l * WL_SIZE;
          PlainOrder S; S.init(ws + WS_AFF, DFF, wl + WL_FO, DFF, MTOK, 1024, G, c); EpiOut E{(bf16_t*)(ws + WS_R3), (float*)(ws + WS_ROWSS)};
          gemm_phase<EpiOut, PlainOrder>(lds, DFF, DFF, DFF, S, E); }
#endif
        GSYNC();
#if PM & 32768
        { PH_BEGIN phase_norm<2>(a, ws, l); }
#endif
        if (l + 1 < DEPTH) GSYNC();
    }
}

extern "C" void kernel_launch(void* const* d_in, const int* in_sizes, int n_in, void* d_out, int out_size, void* d_ws, size_t ws_size, hipStream_t stream) {
    static int grid = 0;
    if (grid == 0) {
        if (n_in != 28 || out_size != NB * SEQ * D || ws_size < WS_END) { fprintf(stderr, "kernel_launch: unexpected shapes (n_in %d, out %d, ws %zu, need %zu)\n", n_in, out_size, ws_size, (size_t)WS_END); grid = -1; return; }
        int dev = 0, cus = 0, per_cu = 0;
        hipGetDevice(&dev); hipDeviceGetAttribute(&cus, hipDeviceAttributeMultiprocessorCount, dev);
        if (hipFuncSetAttribute((const void*)mega, hipFuncAttributeMaxDynamicSharedMemorySize, LDS_BYTES) != hipSuccess) { fprintf(stderr, "kernel_launch: hipFuncSetAttribute failed\n"); grid = -1; return; }
        if (hipOccupancyMaxActiveBlocksPerMultiprocessor(&per_cu, (const void*)mega, 512, LDS_BYTES) != hipSuccess || per_cu < 1) { fprintf(stderr, "kernel_launch: occupancy query says %d\n", per_cu); per_cu = 1; }
        (void)hipGetLastError();
        grid = cus * 1;
        if (grid <= 0) grid = 256;
    }
    if (grid < 0) return;
    if (hipMemsetAsync((char*)d_ws + WS_BAR, 0, 16384, stream) != hipSuccess) { fprintf(stderr, "kernel_launch: memset failed\n"); return; }
    Args a{};
    for (int i = 0; i < 28; ++i) a.in[i] = (const float*)d_in[i];
    a.out = (float*)d_out; a.ws = (unsigned char*)d_ws;
    void* args[] = {&a};
    hipError_t e = hipLaunchCooperativeKernel((const void*)mega, dim3(grid), dim3(512), args, LDS_BYTES, stream);
    if (e != hipSuccess) fprintf(stderr, "kernel_launch: cooperative launch failed: %s (grid %d)\n", hipGetErrorString(e), grid);
}
```

```cpp
#include <hip/hip_runtime.h>
#include <hip/hip_cooperative_groups.h>
#include <cstdio>
namespace cg = cooperative_groups;

#define LAS __attribute__((address_space(3)))
#ifndef PM
#define PM 65535
#endif
#ifndef REP_LRU
#define REP_LRU 1
#endif
#ifndef REP_P0
#define REP_P0 1
#endif
#ifndef REP_CARRY
#define REP_CARRY 1
#endif
#ifndef REP_GEMM
#define REP_GEMM 1
#endif
typedef unsigned short bf16_t;
typedef short bf16x8 __attribute__((ext_vector_type(8)));
typedef float f32x4 __attribute__((ext_vector_type(4)));
typedef unsigned u32x4 __attribute__((ext_vector_type(4)));
typedef float f32x2 __attribute__((ext_vector_type(2)));

constexpr int D = 1024, NB = 8, SEQ = 4096, DEPTH = 4, CTXL = 256, POS = CTXL + SEQ, MTOK = NB * POS;
constexpr int DS5 = 512, NG = 32, DLRU = 512, NH = 8, DIN = 1536, DFF = 2816;
constexpr int TS = 32, SCH = POS / TS, MS = NB * SCH, MSP = 1280, K3 = 768, K1 = 512;
constexpr int LCH = 68;
constexpr float EPS = 1e-6f;
constexpr int LDS_BYTES = 147456;

constexpr size_t WS_CTXR = 0;
constexpr size_t WS_MOD = WS_CTXR + (size_t)NB * CTXL * D * 4;
constexpr size_t WS_WL = WS_MOD + 4 * 9 * 6144 * 4;
constexpr size_t WL_IN = 0, WL_GLU = WL_IN + 3145728, WL_OUT = WL_GLU + 524288, WL_FI = WL_OUT + 2097152, WL_FO = WL_FI + 11534336, WL_LRU = WL_FO + 5767168, WL_SIZE = WL_LRU + 262144;
constexpr size_t WS_BT3 = WS_WL + 4 * WL_SIZE;
constexpr size_t WS_BT1 = WS_BT3 + 25165824;
constexpr size_t WS_AT = WS_BT1 + 8388608;
constexpr size_t WS_BIG = WS_AT + 32768;
constexpr size_t WS_US5 = WS_BIG;
constexpr size_t WS_XG = WS_US5 + 62914560;
constexpr size_t WS_HLOC = WS_XG + 71303168;
constexpr size_t WS_Y1 = WS_HLOC + 35651584;
constexpr size_t BIG_SIZE = 205520896;
constexpr size_t WS_AFF = WS_BIG;
constexpr size_t WS_R2 = WS_BIG + BIG_SIZE;
constexpr size_t WS_R3 = WS_R2 + 71303168;
constexpr size_t WS_ROWSS = WS_R3 + 71303168;
constexpr size_t WS_LAGG = WS_ROWSS + 2228224;
constexpr size_t WS_LHIN = WS_LAGG + 4456448;
constexpr size_t WS_YL = WS_R3, WS_GPF = WS_R3 + 35651584;
constexpr size_t WS_GPR = WS_LHIN + 2228224;
constexpr size_t WS_BAR = WS_GPR + 35651584;
constexpr size_t WS_END = WS_BAR + 16384;

struct Args { const float* in[28]; float* out; unsigned char* ws; };
typedef const Args __attribute__((address_space(4)))* KArgP;
__device__ __forceinline__ KArgP kargs() { KArgP p = (KArgP)__builtin_amdgcn_kernarg_segment_ptr(); asm volatile("" : "+s"(p)); return p; }
__device__ __forceinline__ int fresh_tid() { int t = threadIdx.x; asm volatile("" : "+v"(t)); return t; }
__device__ __forceinline__ int fresh_bid() { int t = blockIdx.x; asm volatile("" : "+s"(t)); return t; }
__device__ __forceinline__ unsigned char* fresh_ws() { unsigned char* w = kargs()->ws; asm volatile("" : "+s"(w)); return w; }

__device__ __forceinline__ f32x2 mk2(float x, float y) { f32x2 r; r.x = x; r.y = y; return r; }
__device__ __forceinline__ unsigned cvt_pk_bf16(float lo, float hi) { unsigned r; asm("v_cvt_pk_bf16_f32 %0, %1, %2" : "=v"(r) : "v"(lo), "v"(hi)); return r; }
__device__ __forceinline__ float bf_lo(unsigned w) { return __uint_as_float(w << 16); }
__device__ __forceinline__ float bf_hi(unsigned w) { return __uint_as_float(w & 0xffff0000u); }
__device__ __forceinline__ float sigmoidf_(float x) { return __frcp_rn(1.0f + __expf(-x)); }
__device__ __forceinline__ float gelu_tanh(float x) { const float u = 1.5957691216057308f * (x + 0.044715f * x * x * x); return x * __frcp_rn(1.0f + __expf(-u)); }
__device__ __forceinline__ float siluf_(float x) { return x * __frcp_rn(1.0f + __expf(-x)); }

constexpr int BM = 256, BK = 64, HALF = 128, HTB = HALF * BK * 2, NXCD = 8, WGM = 8;
__device__ __forceinline__ int lds_byte(int r, int c) { const int st = (r >> 4) * 2 + (c >> 5), rr = r & 15, cc = c & 31, ob = rr * 64 + cc * 2; return st * 1024 + (ob ^ (((ob >> 9) & 1) << 5)); }
__device__ __forceinline__ void stage_rc(int b, int& R, int& C) { const int st = b / 1024, sb = b % 1024, swz = sb ^ (((sb >> 9) & 1) << 5); R = (st >> 1) * 16 + swz / 64; C = (st & 1) * 32 + (swz % 64) / 2; }
__device__ __forceinline__ int perm32(int rho) { const int n = rho >> 4, i = rho & 15; return 8 * (i >> 2) + 4 * n + (i & 3); }

struct Unit { const char* A; const char* B; int pm, pn, g; };

struct PlainOrder {
    const char* A; const char* B; size_t tA, tB; int nM, nN, nwg, G, c;
    __device__ void init(const void* A_, int lda, const void* B_, int ldb, int M, int N, int G_, int c_) {
        A = (const char*)A_; B = (const char*)B_; tA = (size_t)BM * lda * 2; tB = (size_t)BM * ldb * 2; nM = M / BM; nN = N / BM; nwg = nM * nN; G = G_; c = c_; }
    __device__ __forceinline__ bool next(int i, Unit& u) const {
        const long L = (long)i * G + c; if (L >= nwg) return false;
        int wgid = (int)L; { const int q = nwg / NXCD, r = nwg % NXCD, xcd = wgid % NXCD, off = wgid / NXCD; wgid = (xcd < r ? xcd * (q + 1) : r * (q + 1) + (xcd - r) * q) + off; }
        const int nig = WGM * nN, gid = wgid / nig, fm = gid * WGM, gsz = (nM - fm) < WGM ? (nM - fm) : WGM;
        u.pm = fm + ((wgid % nig) % gsz); u.pn = (wgid % nig) / gsz; u.g = 0;
        u.A = A + (size_t)u.pm * tA; u.B = B + (size_t)u.pn * tB; return true;
    }
};
struct BatchOrder {
    const char* A; const char* B; size_t tA, tB, gA, gB; int nM, nN, total, G, c;
    __device__ void init(const void* A_, int lda, size_t gA_, const void* B_, int ldb, size_t gB_, int nM_, int nN_, int ng, int G_, int c_) {
        A = (const char*)A_; B = (const char*)B_; tA = (size_t)BM * lda * 2; tB = (size_t)BM * ldb * 2; gA = gA_; gB = gB_; nM = nM_; nN = nN_; total = nM_ * nN_ * ng; G = G_; c = c_; }
    __device__ __forceinline__ bool next(int i, Unit& u) const {
        const long L = (long)i * G + c; if (L >= total) return false;
        const int per = nM * nN, g = (int)L / per, r = (int)L % per; u.g = g; u.pn = r / nM; u.pm = r % nM;
        u.A = A + (size_t)g * gA + (size_t)u.pm * tA; u.B = B + (size_t)g * gB + (size_t)u.pn * tB; return true;
    }
};

template <class Epi, class Sched>
__device__ __forceinline__ void gemm_phase(LAS unsigned char* lds, const int lda, const int ldb, const int K, const Sched& S, const Epi& E) {
    int tid_ = threadIdx.x; asm volatile("" : "+v"(tid_));
    const int tid = tid_, wid = __builtin_amdgcn_readfirstlane(tid >> 6), lane = tid & 63, wr = wid >> 2, wc = wid & 3, fr = lane & 15, fq = lane >> 4;
    const int nt = K / BK;
    unsigned voffA[2], voffB[2];
#pragma unroll
    for (int i = 0; i < 2; ++i) { int R, C; stage_rc(tid * 16 + i * 8192, R, C); const int Rb = Epi::PERM ? ((R & ~31) + perm32(R & 31)) : R;
        voffA[i] = (unsigned)(R * lda + C) * 2u; voffB[i] = (unsigned)(Rb * ldb + C) * 2u; }
    const size_t kstep = (size_t)(BK * 2);
    const size_t hstepA = (size_t)HALF * lda * 2, hstepB = (size_t)HALF * ldb * 2;
    const unsigned ldsw = (unsigned)wid * 1024u;
    const int aoff = lds_byte(wr * 64 + fr, fq * 8), boff = lds_byte(wc * 32 + fr, fq * 8);
#define PG8_SA(b, h) (((b) * 2 + (h)) * HTB)
#define PG8_SB(b, h) ((4 + (b) * 2 + (h)) * HTB)
#define PG8_STAGE(bufoff, gbase, voff) do { _Pragma("unroll") for (int _i = 0; _i < 2; ++_i) \
        __builtin_amdgcn_global_load_lds((const unsigned*)((const char*)(gbase) + (voff)[_i]), (LAS unsigned*)(lds + (bufoff) + ldsw + _i * 8192), 16, 0, 0); } while (0)
#define PG8_LDA(dst, b, h) do { _Pragma("unroll") for (int m = 0; m < 4; ++m) _Pragma("unroll") for (int k = 0; k < 2; ++k) dst[m][k] = *(const LAS bf16x8*)(lds + PG8_SA(b, h) + aoff + m * 2048 + k * 1024); } while (0)
#define PG8_LDB(dst, b, h) do { _Pragma("unroll") for (int n = 0; n < 2; ++n) _Pragma("unroll") for (int k = 0; k < 2; ++k) dst[n][k] = *(const LAS bf16x8*)(lds + PG8_SB(b, h) + boff + n * 2048 + k * 1024); } while (0)
#define PG8_MMA(ai, bj, At, Bt) do { __builtin_amdgcn_s_setprio(1); _Pragma("unroll") for (int m = 0; m < 4; ++m) _Pragma("unroll") for (int n = 0; n < 2; ++n) _Pragma("unroll") for (int k = 0; k < 2; ++k) \
        acc[ai][bj][m][n] = __builtin_amdgcn_mfma_f32_16x16x32_bf16(Bt[n][k], At[m][k], acc[ai][bj][m][n], 0, 0, 0); __builtin_amdgcn_s_setprio(0); } while (0)
#define PG8_WAIT_V(n) asm volatile("s_waitcnt vmcnt(" #n ")" ::: "memory")
#define PG8_WAIT_L(n) asm volatile("s_waitcnt lgkmcnt(" #n ")" ::: "memory")
#define PG8_BAR __builtin_amdgcn_s_barrier()
#define PG8_SCHED __builtin_amdgcn_sched_barrier(0)
    Unit cur, nxt; int ui = 0;
    if (!S.next(0, cur)) return;
    f32x4 acc[2][2][4][2];
#pragma unroll
    for (int a = 0; a < 2; ++a)
#pragma unroll
        for (int b = 0; b < 2; ++b)
#pragma unroll
            for (int m = 0; m < 4; ++m)
#pragma unroll
                for (int n = 0; n < 2; ++n) acc[a][b][m][n] = (f32x4){0.f, 0.f, 0.f, 0.f};
    bf16x8 At[4][2], B0[2][2], B1[2][2];
    const char* cA = cur.A; const char* cB = cur.B;
    PG8_STAGE(PG8_SB(0, 0), cB, voffB); PG8_STAGE(PG8_SA(0, 0), cA, voffA); PG8_STAGE(PG8_SB(0, 1), cB + hstepB, voffB); PG8_STAGE(PG8_SA(0, 1), cA + hstepA, voffA);
    if (wr == 1) PG8_BAR;
    PG8_WAIT_V(4); PG8_BAR;
    PG8_STAGE(PG8_SB(1, 0), cB + kstep, voffB); PG8_STAGE(PG8_SA(1, 0), cA + kstep, voffA); PG8_STAGE(PG8_SB(1, 1), cB + hstepB + kstep, voffB);
    PG8_WAIT_V(6); PG8_BAR;
    for (;;) {
        const bool has_next = S.next(ui + 1, nxt);
        const char* nA = has_next ? nxt.A : cA; const char* nB = has_next ? nxt.B : cB;
        for (int t = 0; t < nt; t += 2) {
            const bool last = (t == nt - 2);
            const char* a1 = cA + (size_t)(t + 1) * kstep;
            const char* a2 = last ? nA : cA + (size_t)(t + 2) * kstep; const char* b2 = last ? nB : cB + (size_t)(t + 2) * kstep;
            const char* a3 = a2 + kstep; const char* b3 = b2 + kstep;
            PG8_LDB(B0, 0, 0); PG8_SCHED; PG8_LDA(At, 0, 0); PG8_STAGE(PG8_SA(1, 1), a1 + hstepA, voffA);
            PG8_WAIT_L(8); PG8_BAR; PG8_WAIT_L(0); PG8_MMA(0, 0, At, B0); PG8_BAR; PG8_SCHED;
            PG8_LDB(B1, 0, 1); PG8_STAGE(PG8_SB(0, 0), b2, voffB);
            PG8_BAR; PG8_WAIT_L(0); PG8_MMA(0, 1, At, B1); PG8_BAR;
            PG8_LDA(At, 0, 1); PG8_STAGE(PG8_SA(0, 0), a2, voffA);
            PG8_BAR; PG8_WAIT_L(0); PG8_MMA(1, 0, At, B0); PG8_BAR; PG8_SCHED;
            PG8_STAGE(PG8_SB(0, 1), b2 + hstepB, voffB);
            PG8_WAIT_V(6); PG8_BAR; PG8_MMA(1, 1, At, B1); PG8_BAR;
            PG8_LDB(B0, 1, 0); PG8_SCHED; PG8_LDA(At, 1, 0); PG8_STAGE(PG8_SA(0, 1), a2 + hstepA, voffA);
            PG8_WAIT_L(8); PG8_BAR; PG8_WAIT_L(0); PG8_MMA(0, 0, At, B0); PG8_BAR; PG8_SCHED;
            PG8_LDB(B1, 1, 1); PG8_STAGE(PG8_SB(1, 0), b3, voffB);
            PG8_BAR; PG8_WAIT_L(0); PG8_MMA(0, 1, At, B1); PG8_BAR;
            PG8_LDA(At, 1, 1); PG8_STAGE(PG8_SA(1, 0), a3, voffA);
            PG8_BAR; PG8_WAIT_L(0); PG8_MMA(1, 0, At, B0); PG8_BAR; PG8_SCHED;
            PG8_STAGE(PG8_SB(1, 1), b3 + hstepB, voffB);
            PG8_WAIT_V(6); PG8_BAR; PG8_MMA(1, 1, At, B1); PG8_BAR;
        }
        E(acc, cur, wr, wc, fr, fq);
        if (!has_next) break;
#pragma unroll
        for (int a = 0; a < 2; ++a)
#pragma unroll
            for (int b = 0; b < 2; ++b)
#pragma unroll
                for (int m = 0; m < 4; ++m)
#pragma unroll
                    for (int n = 0; n < 2; ++n) acc[a][b][m][n] = (f32x4){0.f, 0.f, 0.f, 0.f};
        cur = nxt; cA = nA; cB = nB; ++ui;
    }
    PG8_WAIT_V(0);
    if (wr == 0) PG8_BAR;
    PG8_BAR;
#undef PG8_SA
#undef PG8_SB
#undef PG8_STAGE
#undef PG8_LDA
#undef PG8_LDB
#undef PG8_MMA
#undef PG8_WAIT_V
#undef PG8_WAIT_L
#undef PG8_BAR
#undef PG8_SCHED
}

typedef f32x4 AccT[2][2][4][2];

struct EpiIn {
    static constexpr bool PERM = true;
    bf16_t* us5; bf16_t* xg;
    __device__ __forceinline__ void operator()(const AccT& acc, const Unit& u, int wr, int wc, int fr, int fq) const {
#pragma unroll
        for (int ai = 0; ai < 2; ++ai)
#pragma unroll
            for (int m = 0; m < 4; ++m) {
                const int row = u.pm * BM + ai * HALF + wr * 64 + m * 16 + fr;
#pragma unroll
                for (int bj = 0; bj < 2; ++bj) {
                    const int col0 = u.pn * BM + bj * HALF + wc * 32 + 8 * fq;
                    const f32x4 v0 = acc[ai][bj][m][0], v1 = acc[ai][bj][m][1];
                    u32x4 w; w.x = cvt_pk_bf16(v0[0], v0[1]); w.y = cvt_pk_bf16(v0[2], v0[3]); w.z = cvt_pk_bf16(v1[0], v1[1]); w.w = cvt_pk_bf16(v1[2], v1[3]);
                    if (u.pn < 2) { const int g = col0 >> 4, p0 = col0 & 15, mr = row >> 5, s = row & 31;
                        *(u32x4*)(us5 + ((size_t)g * MSP + mr) * K3 + s * 16 + p0) = w; }
                    else *(u32x4*)(xg + (size_t)row * 1024 + (col0 - 512)) = w;
                }
            }
    }
};
struct EpiHloc {
    static constexpr bool PERM = false;
    float* hloc;
    __device__ __forceinline__ void operator()(const AccT& acc, const Unit& u, int wr, int wc, int fr, int fq) const {
#pragma unroll
        for (int ai = 0; ai < 2; ++ai)
#pragma unroll
            for (int m = 0; m < 4; ++m) {
                const int row = u.pm * BM + ai * HALF + wr * 64 + m * 16 + fr;
                if (row < MS) {
                    float* rp = hloc + ((size_t)u.g * MS + row) * 256 + wc * 32 + 4 * fq;
#pragma unroll
                    for (int bj = 0; bj < 2; ++bj)
#pragma unroll
                        for (int n = 0; n < 2; ++n) *(f32x4*)(rp + bj * HALF + n * 16) = acc[ai][bj][m][n];
                }
            }
    }
};
struct EpiY1 {
    static constexpr bool PERM = true;
    bf16_t* y1;
    __device__ __forceinline__ void operator()(const AccT& acc, const Unit& u, int wr, int wc, int fr, int fq) const {
#pragma unroll
        for (int ai = 0; ai < 2; ++ai)
#pragma unroll
            for (int m = 0; m < 4; ++m) {
                const int row = u.pm * BM + ai * HALF + wr * 64 + m * 16 + fr;
                if (row < MS) {
#pragma unroll
                    for (int bj = 0; bj < 2; ++bj) {
                        const int col0 = u.pn * BM + bj * HALF + wc * 32 + 8 * fq, t = col0 >> 4, q0 = col0 & 15;
                        const f32x4 v0 = acc[ai][bj][m][0], v1 = acc[ai][bj][m][1];
                        u32x4 w; w.x = cvt_pk_bf16(gelu_tanh(v0[0]), gelu_tanh(v0[1])); w.y = cvt_pk_bf16(gelu_tanh(v0[2]), gelu_tanh(v0[3]));
                        w.z = cvt_pk_bf16(gelu_tanh(v1[0]), gelu_tanh(v1[1])); w.w = cvt_pk_bf16(gelu_tanh(v1[2]), gelu_tanh(v1[3]));
                        *(u32x4*)(y1 + ((size_t)row * TS + t) * 512 + u.g * 16 + q0) = w;
                    }
                }
            }
    }
};
struct EpiGlu {
    static constexpr bool PERM = true;
    const bf16_t* y1; bf16_t* y; const float* bias;
    __device__ __forceinline__ void operator()(const AccT& acc, const Unit& u, int wr, int wc, int fr, int fq) const {
#pragma unroll
        for (int bj = 0; bj < 2; ++bj) {
            const int col0 = u.pn * BM + bj * HALF + wc * 32 + 8 * fq;
            const f32x4 b0 = *(const f32x4*)(bias + col0), b1 = *(const f32x4*)(bias + col0 + 4);
#pragma unroll
            for (int ai = 0; ai < 2; ++ai)
#pragma unroll
                for (int m = 0; m < 4; ++m) {
                    const int row = u.pm * BM + ai * HALF + wr * 64 + m * 16 + fr;
                    const u32x4 yv = *(const u32x4*)(y1 + (size_t)row * 512 + col0);
                    const f32x4 v0 = acc[ai][bj][m][0] + b0, v1 = acc[ai][bj][m][1] + b1;
                    u32x4 w;
                    w.x = cvt_pk_bf16(bf_lo(yv.x) * sigmoidf_(v0[0]), bf_hi(yv.x) * sigmoidf_(v0[1]));
                    w.y = cvt_pk_bf16(bf_lo(yv.y) * sigmoidf_(v0[2]), bf_hi(yv.y) * sigmoidf_(v0[3]));
                    w.z = cvt_pk_bf16(bf_lo(yv.z) * sigmoidf_(v1[0]), bf_hi(yv.z) * sigmoidf_(v1[1]));
                    w.w = cvt_pk_bf16(bf_lo(yv.w) * sigmoidf_(v1[2]), bf_hi(yv.w) * sigmoidf_(v1[3]));
                    *(u32x4*)(y + (size_t)row * 1024 + col0) = w;
                }
        }
    }
};
struct EpiOut {
    static constexpr bool PERM = true;
    bf16_t* o; float* rowss;
    __device__ __forceinline__ void operator()(const AccT& acc, const Unit& u, int wr, int wc, int fr, int fq) const {
#pragma unroll
        for (int ai = 0; ai < 2; ++ai)
#pragma unroll
            for (int m = 0; m < 4; ++m) {
                const int row = u.pm * BM + ai * HALF + wr * 64 + m * 16 + fr;
                float s = 0.f;
#pragma unroll
                for (int bj = 0; bj < 2; ++bj) {
                    const int col0 = u.pn * BM + bj * HALF + wc * 32 + 8 * fq;
                    const f32x4 v0 = acc[ai][bj][m][0], v1 = acc[ai][bj][m][1];
                    s += (v0[0] * v0[0] + v0[1] * v0[1]) + (v0[2] * v0[2] + v0[3] * v0[3]) + (v1[0] * v1[0] + v1[1] * v1[1]) + (v1[2] * v1[2] + v1[3] * v1[3]);
                    u32x4 w; w.x = cvt_pk_bf16(v0[0], v0[1]); w.y = cvt_pk_bf16(v0[2], v0[3]); w.z = cvt_pk_bf16(v1[0], v1[1]); w.w = cvt_pk_bf16(v1[2], v1[3]);
                    *(u32x4*)(o + (size_t)row * 1024 + col0) = w;
                }
                s += __shfl_xor(s, 16); s += __shfl_xor(s, 32);
                if (fq == 0) rowss[(size_t)row * 16 + u.pn * 4 + wc] = s;
            }
    }
};
struct EpiFfn {
    static constexpr bool PERM = true;
    bf16_t* aff;
    __device__ __forceinline__ void operator()(const AccT& acc, const Unit& u, int wr, int wc, int fr, int fq) const {
#pragma unroll
        for (int ai = 0; ai < 2; ++ai)
#pragma unroll
            for (int m = 0; m < 4; ++m) {
                const int row = u.pm * BM + ai * HALF + wr * 64 + m * 16 + fr;
                const f32x4 g0 = acc[ai][0][m][0], g1 = acc[ai][0][m][1], u0 = acc[ai][1][m][0], u1 = acc[ai][1][m][1];
                u32x4 w;
                w.x = cvt_pk_bf16(siluf_(g0[0]) * u0[0], siluf_(g0[1]) * u0[1]); w.y = cvt_pk_bf16(siluf_(g0[2]) * u0[2], siluf_(g0[3]) * u0[3]);
                w.z = cvt_pk_bf16(siluf_(g1[0]) * u1[0], siluf_(g1[1]) * u1[1]); w.w = cvt_pk_bf16(siluf_(g1[2]) * u1[2], siluf_(g1[3]) * u1[3]);
                *(u32x4*)(aff + (size_t)row * DFF + u.pn * 128 + wc * 32 + 8 * fq) = w;
            }
    }
};

__device__ void phase_mod(KArgP a, unsigned char* ws, LAS unsigned char* lds) {
    const int tid = fresh_tid(), lane = tid & 63, wv = tid >> 6;
    LAS float* sc = (LAS float*)lds;
    LAS float* red = sc + 9216;
    for (int idx = tid; idx < 9216; idx += 512) { const int bb = idx >> 10, k = idx & 1023; const float v = bb < 8 ? a->in[1][bb * 1024 + k] : a->in[3][k]; sc[idx] = siluf_(v); }
    __syncthreads();
    float* mod = (float*)(ws + WS_MOD);
    for (int u = blockIdx.x; u < 384; u += gridDim.x) {
        const int l = u / 96, jg = u % 96, j = jg * 64 + lane;
        const float* w = a->in[4] + ((size_t)l * 1024 + wv * 128) * 6144 + j;
        float acc[9];
#pragma unroll
        for (int bb = 0; bb < 9; ++bb) acc[bb] = 0.f;
        for (int k0 = 0; k0 < 128; k0 += 8) {
            float wv8[8];
#pragma unroll
            for (int e = 0; e < 8; ++e) wv8[e] = w[(size_t)(k0 + e) * 6144];
#pragma unroll
            for (int e = 0; e < 8; ++e)
#pragma unroll
                for (int bb = 0; bb < 9; ++bb) acc[bb] += sc[bb * 1024 + wv * 128 + k0 + e] * wv8[e];
        }
#pragma unroll
        for (int bb = 0; bb < 9; ++bb) red[(wv * 9 + bb) * 64 + lane] = acc[bb];
        __syncthreads();
        for (int o = tid; o < 576; o += 512) { const int bb = o >> 6, ln = o & 63; float s = a->in[5][l * 6144 + jg * 64 + ln];
#pragma unroll
            for (int w8 = 0; w8 < 8; ++w8) s += red[(w8 * 9 + bb) * 64 + ln];
            mod[((size_t)l * 9 + bb) * 6144 + jg * 64 + ln] = s; }
        __syncthreads();
    }
}

__device__ __forceinline__ void transpose_tile(const float* src, int N, bf16_t* dst, int Kd, int k0, int n0, int drow0, LAS float* t) {
    const int tid = fresh_tid();
#pragma unroll
    for (int i = 0; i < 16; ++i) { const int k = i * 8 + (tid >> 6), n = tid & 63; t[k * 65 + n] = src[(size_t)(k0 + k) * N + n0 + n]; }
    __syncthreads();
#pragma unroll
    for (int i = 0; i < 8; ++i) { const int n = i * 8 + (tid >> 6), kk = (tid & 63) * 2;
        *(unsigned*)(dst + (size_t)(drow0 + n) * Kd + k0 + kk) = cvt_pk_bf16(t[kk * 65 + n], t[(kk + 1) * 65 + n]); }
    __syncthreads();
}
__device__ void phase_wconv(KArgP a, unsigned char* ws, LAS unsigned char* lds) {
    LAS float* t = (LAS float*)lds;
    for (int T = blockIdx.x; T < 4 * 1408; T += gridDim.x) {
        const int l = T / 1408; int r = T % 1408;
        unsigned char* wl = ws + WS_WL + (size_t)l * WL_SIZE;
        if (r < 192) { const int kt = r / 24, nt = r % 24; transpose_tile(a->in[7] + (size_t)l * 1024 * 1536, 1536, (bf16_t*)(wl + WL_IN), 1024, kt * 128, nt * 64, nt * 64, t); }
        else if (r < 224) { r -= 192; const int kt = r / 8, nt = r % 8; transpose_tile(a->in[16] + (size_t)l * 512 * 512, 512, (bf16_t*)(wl + WL_GLU), 512, kt * 128, nt * 64, nt * 64, t); }
        else if (r < 352) { r -= 224; const int kt = r / 16, nt = r % 16; transpose_tile(a->in[25] + (size_t)l * 1024 * 1024, 1024, (bf16_t*)(wl + WL_OUT), 1024, kt * 128, nt * 64, nt * 64, t); }
        else if (r < 1056) { r -= 352; const int kt = r / 88, nt = r % 88; const int n0 = nt * 64;
            const int drow0 = n0 < DFF ? 256 * (n0 / 128) + (n0 % 128) : 256 * ((n0 - DFF) / 128) + 128 + ((n0 - DFF) % 128);
            transpose_tile(a->in[26] + (size_t)l * 1024 * 5632, 5632, (bf16_t*)(wl + WL_FI), 1024, kt * 128, n0, drow0, t); }
        else { r -= 1056; const int kt = r / 16, nt = r % 16; transpose_tile(a->in[27] + (size_t)l * DFF * 1024, 1024, (bf16_t*)(wl + WL_FO), DFF, kt * 128, nt * 64, nt * 64, t); }
    }
    for (int idx = fresh_bid() * 512 + fresh_tid(); idx < 4 * 8 * 4 * 64 * 64; idx += gridDim.x * 512) {
        const int j = idx & 63, k = (idx >> 6) & 63, nb = (idx >> 12) & 3, h = (idx >> 14) & 7, l = idx >> 17;
        const float* src = (nb & 1) ? a->in[22] : a->in[20];
        const float v = src[((((size_t)l * 2 + (nb >> 1)) * 8 + h) * 64 + k) * 64 + j];
        bf16_t* dst = (bf16_t*)(ws + WS_WL + (size_t)l * WL_SIZE + WL_LRU);
        dst[((size_t)h * 256 + nb * 64 + j) * 64 + k] = (bf16_t)(cvt_pk_bf16(v, 0.f) & 0xffffu);
    }
}

__device__ void s5tab_group(KArgP a, unsigned char* ws, LAS unsigned char* lds, int layer, int g) {
    const int tid = fresh_tid();
    LAS f32x2* abp = (LAS f32x2*)lds;
    LAS f32x2* bbv = (LAS f32x2*)(lds + 33792);
    LAS f32x2* ccv = (LAS f32x2*)(lds + 50176);
    LAS float* kt = (LAS float*)(lds + 66560);
    if (tid < 128) {
        const int d = tid >> 6, n = tid & 63, base = (layer * 2 + d) * 32 + g;
        const float dt = expf(a->in[10][base]);
        const float are = a->in[8][base * 64 + n], aim = a->in[9][base * 64 + n];
        for (int tau = 0; tau <= 32; ++tau) {
            const float mag = expf(are * dt * (float)tau);
            float rev = aim * dt * (float)tau * 0.15915494309189535f; rev -= rintf(rev);
            const float ang = rev * 6.283185307179586f;
            abp[(d * 64 + n) * 33 + tau] = mk2(mag * cosf(ang), mag * sinf(ang));
        }
        const float zr = are * dt; float rev = aim * dt * 0.15915494309189535f; rev -= rintf(rev); const float zi = rev * 6.283185307179586f;
        const float em1 = expm1f(zr), cz = cosf(zi), sz = sinf(zi), s2 = sinf(0.5f * zi);
        const float nr = em1 * cz - 2.f * s2 * s2, abim = (em1 + 1.f) * sz;
        const float den = are * are + aim * aim;
        const float fre = (nr * are + abim * aim) / den, fim = (abim * are - nr * aim) / den;
        for (int p = 0; p < 16; ++p) {
            const float br = a->in[11][((size_t)base * 64 + n) * 16 + p], bi = a->in[12][((size_t)base * 64 + n) * 16 + p];
            bbv[(d * 64 + n) * 16 + p] = mk2(fre * br - fim * bi, fre * bi + fim * br);
        }
        for (int q = 0; q < 16; ++q) ccv[(d * 16 + q) * 64 + n] = mk2(a->in[13][((size_t)base * 16 + q) * 64 + n], a->in[14][((size_t)base * 16 + q) * 64 + n]);
        ((f32x2*)(ws + WS_AT))[(g * 2 + d) * 64 + n] = abp[(d * 64 + n) * 33 + 32];
    }
    __syncthreads();
    for (int it = 0; it < 2; ++it) {
        const int combo = tid + it * 512, d = combo >> 9, tau = (combo >> 4) & 31, q = combo & 15;
        float acc[16];
#pragma unroll
        for (int p = 0; p < 16; ++p) acc[p] = 0.f;
        for (int n = 0; n < 64; ++n) {
            const f32x2 c = ccv[(d * 16 + q) * 64 + n], pw = abp[(d * 64 + n) * 33 + tau];
            const float wr_ = c.x * pw.x - c.y * pw.y, wi_ = c.x * pw.y + c.y * pw.x;
#pragma unroll
            for (int p = 0; p < 16; ++p) { const f32x2 bv = bbv[(d * 64 + n) * 16 + p]; acc[p] += wr_ * bv.x - wi_ * bv.y; }
        }
#pragma unroll
        for (int p = 0; p < 16; ++p) kt[((d * 32 + tau) * 16 + q) * 16 + p] = acc[p];
    }
    __syncthreads();
    bf16_t* bt3 = (bf16_t*)(ws + WS_BT3) + (size_t)g * 512 * K3;
    bf16_t* bt1 = (bf16_t*)(ws + WS_BT1) + (size_t)g * 256 * K1;
    const float* dvec = a->in[15] + layer * 512 + g * 16;
    for (int i = 0; i < 64; ++i) {
        const int it = tid + 512 * i, row = it >> 6, s = (it >> 1) & 31, ph = it & 1, t = row >> 4, q = row & 15;
        float v[8];
#pragma unroll
        for (int e = 0; e < 8; ++e) { const int p = ph * 8 + e; float x = 0.f;
            if (s <= t) x += kt[(((t - s)) * 16 + q) * 16 + p];
            if (s >= t) x += kt[((32 + (s - t)) * 16 + q) * 16 + p];
            if (s == t && p == q) x += dvec[q];
            v[e] = x; }
        u32x4 w; w.x = cvt_pk_bf16(v[0], v[1]); w.y = cvt_pk_bf16(v[2], v[3]); w.z = cvt_pk_bf16(v[4], v[5]); w.w = cvt_pk_bf16(v[6], v[7]);
        *(u32x4*)(bt3 + (size_t)row * K3 + s * 16 + ph * 8) = w;
    }
    for (int i = 0; i < 32; ++i) {
        const int it = tid + 512 * i, row = it >> 5, c8 = (it & 31) * 8, t = row >> 4, q = row & 15, d = c8 >> 7, n0 = (c8 & 127) >> 1;
        const int pw = d == 0 ? t + 1 : 32 - t;
        float v[8];
#pragma unroll
        for (int e = 0; e < 4; ++e) { const f32x2 c = ccv[(d * 16 + q) * 64 + n0 + e], pa = abp[(d * 64 + n0 + e) * 33 + pw];
            v[2 * e] = c.x * pa.x - c.y * pa.y; v[2 * e + 1] = -(c.x * pa.y + c.y * pa.x); }
        u32x4 w; w.x = cvt_pk_bf16(v[0], v[1]); w.y = cvt_pk_bf16(v[2], v[3]); w.z = cvt_pk_bf16(v[4], v[5]); w.w = cvt_pk_bf16(v[6], v[7]);
        *(u32x4*)(bt3 + (size_t)row * K3 + 512 + c8) = w;
    }
    for (int i = 0; i < 32; ++i) {
        const int it = tid + 512 * i, row = it >> 6, k8 = (it & 63) * 8, s = k8 >> 4, p0 = k8 & 15, d = row >> 7, n = (row & 127) >> 1, ci = row & 1;
        const int pw = d == 0 ? 31 - s : s;
        const f32x2 pa = abp[(d * 64 + n) * 33 + pw];
        float v[8];
#pragma unroll
        for (int e = 0; e < 8; ++e) { const f32x2 bv = bbv[(d * 64 + n) * 16 + p0 + e]; v[e] = ci ? (pa.x * bv.y + pa.y * bv.x) : (pa.x * bv.x - pa.y * bv.y); }
        u32x4 w; w.x = cvt_pk_bf16(v[0], v[1]); w.y = cvt_pk_bf16(v[2], v[3]); w.z = cvt_pk_bf16(v[4], v[5]); w.w = cvt_pk_bf16(v[6], v[7]);
        *(u32x4*)(bt1 + (size_t)row * K1 + k8) = w;
    }
    __syncthreads();
}

template <int MODE>
__device__ void phase_norm(KArgP a, unsigned char* ws, int layer) {
    const int tid = fresh_tid();
    const int lane = tid & 63, wid = tid >> 6;
    const int gw = fresh_bid() * 8 + wid, GW = gridDim.x * 8;
    const float* mod = (const float*)(ws + WS_MOD);
    const float* gains = a->in[6];
    const bool from_input = (MODE == 0) || (MODE == 1 && layer == 0);
    for (int R = gw; R < MTOK; R += GW) {
        const int b = R / POS, pos = R % POS; const bool isctx = pos < CTXL; const int cb = isctx ? 8 : b;
        const float* xsrc; float* xdst;
        if (isctx) { const size_t o = ((size_t)b * CTXL + pos) * D; xdst = (float*)(ws + WS_CTXR) + o; xsrc = from_input ? a->in[2] + o : xdst; }
        else { const size_t o = ((size_t)b * SEQ + (pos - CTXL)) * D; xdst = a->out + o; xsrc = from_input ? a->in[0] + o : xdst; }
        float x[16];
#pragma unroll
        for (int i = 0; i < 2; ++i) { const int c0 = lane * 8 + 512 * i; const f32x4 p = *(const f32x4*)(xsrc + c0), q = *(const f32x4*)(xsrc + c0 + 4);
            x[8 * i + 0] = p[0]; x[8 * i + 1] = p[1]; x[8 * i + 2] = p[2]; x[8 * i + 3] = p[3]; x[8 * i + 4] = q[0]; x[8 * i + 5] = q[1]; x[8 * i + 6] = q[2]; x[8 * i + 7] = q[3]; }
        if (MODE != 0) {
            const float* rs = (const float*)(ws + WS_ROWSS) + (size_t)R * 16;
            const f32x4 r0 = *(const f32x4*)rs, r1 = *(const f32x4*)(rs + 4), r2 = *(const f32x4*)(rs + 8), r3 = *(const f32x4*)(rs + 12);
            const float ss = ((r0[0] + r0[1]) + (r0[2] + r0[3])) + ((r1[0] + r1[1]) + (r1[2] + r1[3])) + ((r2[0] + r2[1]) + (r2[2] + r2[3])) + ((r3[0] + r3[1]) + (r3[2] + r3[3]));
            const float rstd = rsqrtf(ss * (1.0f / 1024.0f) + EPS);
            const bf16_t* o = (const bf16_t*)(ws + WS_R3) + (size_t)R * D;
            const float* gate = mod + ((size_t)layer * 9 + cb) * 6144 + (MODE == 1 ? 2 : 5) * 1024;
            const float* gpost = gains + ((size_t)layer * 4 + (MODE == 1 ? 1 : 3)) * 1024;
#pragma unroll
            for (int i = 0; i < 2; ++i) { const int c0 = lane * 8 + 512 * i; const u32x4 ov = *(const u32x4*)(o + c0);
                const float of[8] = {bf_lo(ov.x), bf_hi(ov.x), bf_lo(ov.y), bf_hi(ov.y), bf_lo(ov.z), bf_hi(ov.z), bf_lo(ov.w), bf_hi(ov.w)};
                const f32x4 g0 = *(const f32x4*)(gate + c0), g1 = *(const f32x4*)(gate + c0 + 4), p0 = *(const f32x4*)(gpost + c0), p1 = *(const f32x4*)(gpost + c0 + 4);
#pragma unroll
                for (int e = 0; e < 4; ++e) { x[8 * i + e] += g0[e] * ((of[e] * rstd) * p0[e]); x[8 * i + 4 + e] += g1[e] * ((of[4 + e] * rstd) * p1[e]); }
                *(f32x4*)(xdst + c0) = (f32x4){x[8 * i], x[8 * i + 1], x[8 * i + 2], x[8 * i + 3]}; *(f32x4*)(xdst + c0 + 4) = (f32x4){x[8 * i + 4], x[8 * i + 5], x[8 * i + 6], x[8 * i + 7]}; }
        }
        if (MODE == 2 && layer == DEPTH - 1) continue;
        float s2 = 0.f;
#pragma unroll
        for (int e = 0; e < 16; ++e) s2 += x[e] * x[e];
#pragma unroll
        for (int off = 32; off >= 1; off >>= 1) s2 += __shfl_xor(s2, off);
        const float rstd2 = rsqrtf(s2 * (1.0f / 1024.0f) + EPS);
        const int ln = MODE == 2 ? layer + 1 : layer;
        const float* gpre = gains + ((size_t)ln * 4 + (MODE == 1 ? 2 : 0)) * 1024;
        const float* shp = mod + ((size_t)ln * 9 + cb) * 6144 + (MODE == 1 ? 3 : 0) * 1024;
        const float* scp = shp + 1024;
        bf16_t* h = (bf16_t*)(ws + WS_R2) + (size_t)R * D;
#pragma unroll
        for (int i = 0; i < 2; ++i) { const int c0 = lane * 8 + 512 * i; float hv[8];
            const f32x4 g0 = *(const f32x4*)(gpre + c0), g1 = *(const f32x4*)(gpre + c0 + 4), s0 = *(const f32x4*)(shp + c0), s1 = *(const f32x4*)(shp + c0 + 4), c0v = *(const f32x4*)(scp + c0), c1v = *(const f32x4*)(scp + c0 + 4);
#pragma unroll
            for (int e = 0; e < 4; ++e) { hv[e] = ((x[8 * i + e] * rstd2) * g0[e]) * (1.f + c0v[e]) + s0[e]; hv[4 + e] = ((x[8 * i + 4 + e] * rstd2) * g1[e]) * (1.f + c1v[e]) + s1[e]; }
            u32x4 w; w.x = cvt_pk_bf16(hv[0], hv[1]); w.y = cvt_pk_bf16(hv[2], hv[3]); w.z = cvt_pk_bf16(hv[4], hv[5]); w.w = cvt_pk_bf16(hv[6], hv[7]);
            *(u32x4*)(h + c0) = w; }
    }
}

__device__ __forceinline__ int lru_tok(int b, int cl, int j) {
    if (cl < 4) { const int p = cl * 64 + j; return (p >= 0 && p < CTXL) ? b * POS + p : -1; }
    const int jj = (cl - 4) * 64 + j; if (jj < 0 || jj >= SEQ) return -1;
    return b * POS + CTXL + (jj & 63) * 64 + (jj >> 6);
}
template <int D>
__device__ __forceinline__ void lru_epi_scan(const f32x4 (&acc)[2][4], float brg, float big, float sp, const LAS float* xcf, LAS float* Hs, LAS float* Ps, int ch, int fq, int lane, float& Atot, float& Htot) {
    float hl[4][4], pl[4][4];
    float cA = 1.f, cH = 0.f;
#pragma unroll
    for (int mi = 0; mi < 4; ++mi) {
        const int m = D ? 3 - mi : mi;
        float av[4], bv[4];
#pragma unroll
        for (int rg = 0; rg < 4; ++rg) {
            const int t = 16 * m + 4 * fq + rg;
            const float r = sigmoidf_(acc[0][m][rg] + brg), ig = sigmoidf_(acc[1][m][rg] + big);
            const float la = -8.0f * r * sp, z = 2.f * la;
            av[rg] = __expf(la);
            const float om = z > -0.3f ? -z * (1.f + 0.5f * z * (1.f + 0.33333333f * z * (1.f + 0.25f * z * (1.f + 0.2f * z * (1.f + 0.16666667f * z))))) : 1.f - __expf(z);
            bv[rg] = sqrtf(om) * ig * xcf[t * 64 + ch];
        }
        float H = 0.f, P = 1.f;
#pragma unroll
        for (int qi = 0; qi < 4; ++qi) { const int rg = D ? 3 - qi : qi; H = av[rg] * H + bv[rg]; P *= av[rg]; hl[m][rg] = H; pl[m][rg] = P; }
        float A = P, Hh = H;
        { const float A1 = __shfl(A, D ? lane + 16 : lane - 16), H1 = __shfl(Hh, D ? lane + 16 : lane - 16); const bool ok = D ? (fq <= 2) : (fq >= 1); if (ok) { Hh = A * H1 + Hh; A = A1 * A; } }
        { const float A2 = __shfl(A, D ? lane + 32 : lane - 32), H2 = __shfl(Hh, D ? lane + 32 : lane - 32); const bool ok = D ? (fq <= 1) : (fq >= 2); if (ok) { Hh = A * H2 + Hh; A = A2 * A; } }
        float Ae = __shfl(A, D ? lane + 16 : lane - 16), He = __shfl(Hh, D ? lane + 16 : lane - 16);
        if (D ? (fq == 3) : (fq == 0)) { Ae = 1.f; He = 0.f; }
        const float At = __shfl(A, (lane & 15) + (D ? 0 : 48)), Ht = __shfl(Hh, (lane & 15) + (D ? 0 : 48));
        const float Pin = cA * Ae, Hin = Ae * cH + He;
#pragma unroll
        for (int rg = 0; rg < 4; ++rg) { hl[m][rg] += pl[m][rg] * Hin; pl[m][rg] *= Pin; }
        cH = At * cH + Ht; cA *= At;
    }
    Atot = cA; Htot = cH;
#pragma unroll
    for (int m = 0; m < 4; ++m)
#pragma unroll
        for (int rg = 0; rg < 4; ++rg) { const int t = 16 * m + 4 * fq + rg; Hs[t * 68 + ch] = hl[m][rg]; Ps[t * 68 + ch] = pl[m][rg]; }
}
__device__ __forceinline__ void lru_prefetch(const bf16_t* xg, int U, int tid, u32x4& p0, u32x4& p1, u32x4& pg) {
    const int head = U & 7, bc = U >> 3, b = bc / LCH, cl = bc % LCH;
    const int c8 = (tid & 7) * 8;
    { const int tok = lru_tok(b, cl, (tid >> 3) - 2); p0 = (u32x4){0u, 0u, 0u, 0u}; if (tok >= 0) p0 = *(const u32x4*)(xg + (size_t)tok * 1024 + head * 64 + c8); }
    p1 = (u32x4){0u, 0u, 0u, 0u};
    if (tid < 24) { const int tok = lru_tok(b, cl, 64 + (tid >> 3) - 2); if (tok >= 0) p1 = *(const u32x4*)(xg + (size_t)tok * 1024 + head * 64 + c8); }
    { const int tok = lru_tok(b, cl, tid >> 3); pg = *(const u32x4*)(xg + (size_t)tok * 1024 + 512 + head * 64 + c8); }
}
__device__ void phase_lru(KArgP a, unsigned char* ws, LAS unsigned char* lds, int layer) {
    const int tid = fresh_tid(), lane = tid & 63, wv = tid >> 6, bid = fresh_bid();
    LAS float* xr_s = (LAS float*)lds;
    LAS float* xcf = (LAS float*)(lds + 17408);
    LAS bf16_t* xcb = (LAS bf16_t*)(lds + 33792);
    LAS float* Hs = (LAS float*)(lds + 43008);
    LAS float* Ps = (LAS float*)(lds + 77824);
    const bf16_t* xg = (const bf16_t*)(ws + WS_XG);
    const int total = NB * LCH * NH;
    const int t_ = tid >> 3, c8 = (tid & 7) * 8;
    const int d = wv >> 2, cbk = wv & 3, fr = lane & 15, fq = lane >> 4, ch = cbk * 16 + fr;
    int cur_head = -1;
    float cw[4][8], cbias[8], brg = 0.f, big = 0.f, sp = 0.f;
    bf16x8 Bf[2][2];
    u32x4 p0, p1, pg;
    int U = (int)gridDim.x - 1 - bid;
    if (U < total) lru_prefetch(xg, U, tid, p0, p1, pg);
    while (U < total) {
        const int head = U & 7, bc = U >> 3, b = bc / LCH, cl = bc % LCH;
        if (head != cur_head) {
            cur_head = head;
#pragma unroll
            for (int k = 0; k < 4; ++k) { const float* p = a->in[18] + ((size_t)layer * 4 + k) * 512 + head * 64 + c8; const f32x4 u0 = *(const f32x4*)p, u1 = *(const f32x4*)(p + 4);
                cw[k][0] = u0[0]; cw[k][1] = u0[1]; cw[k][2] = u0[2]; cw[k][3] = u0[3]; cw[k][4] = u1[0]; cw[k][5] = u1[1]; cw[k][6] = u1[2]; cw[k][7] = u1[3]; }
            { const float* p = a->in[19] + layer * 512 + head * 64 + c8; const f32x4 u0 = *(const f32x4*)p, u1 = *(const f32x4*)(p + 4);
                cbias[0] = u0[0]; cbias[1] = u0[1]; cbias[2] = u0[2]; cbias[3] = u0[3]; cbias[4] = u1[0]; cbias[5] = u1[1]; cbias[6] = u1[2]; cbias[7] = u1[3]; }
            const bf16_t* Wl = (const bf16_t*)(ws + WS_WL + (size_t)layer * WL_SIZE + WL_LRU) + (size_t)head * 256 * 64;
#pragma unroll
            for (int gt = 0; gt < 2; ++gt)
#pragma unroll
                for (int ks = 0; ks < 2; ++ks) Bf[gt][ks] = *(const bf16x8*)(Wl + (size_t)((d * 2 + gt) * 64 + ch) * 64 + ks * 32 + fq * 8);
            const int pidx = (layer * 2 + d) * 512 + head * 64 + ch;
            brg = a->in[21][pidx]; big = a->in[23][pidx];
            const float ex = __expf(-a->in[24][pidx]);
            sp = ex < 0.1f ? ex * (1.f - ex * (0.5f - ex * (0.33333333f - ex * 0.25f))) : __logf(1.f + ex);
        }
        { LAS float* dp = xr_s + t_ * 64 + c8;
          dp[0] = bf_lo(p0.x); dp[1] = bf_hi(p0.x); dp[2] = bf_lo(p0.y); dp[3] = bf_hi(p0.y); dp[4] = bf_lo(p0.z); dp[5] = bf_hi(p0.z); dp[6] = bf_lo(p0.w); dp[7] = bf_hi(p0.w);
          if (tid < 24) { LAS float* dq = xr_s + (64 + t_) * 64 + c8;
            dq[0] = bf_lo(p1.x); dq[1] = bf_hi(p1.x); dq[2] = bf_lo(p1.y); dq[3] = bf_hi(p1.y); dq[4] = bf_lo(p1.z); dq[5] = bf_hi(p1.z); dq[6] = bf_lo(p1.w); dq[7] = bf_hi(p1.w); } }
        const u32x4 gv = pg;
        __syncthreads();
        const int Un = U + (int)gridDim.x;
        if (Un < total) lru_prefetch(xg, Un, tid, p0, p1, pg);
#pragma unroll
        for (int e = 0; e < 8; ++e) {
            float v = cbias[e];
#pragma unroll
            for (int k = 0; k < 4; ++k) v += cw[k][e] * xr_s[(t_ + k) * 64 + c8 + e];
            xcf[t_ * 64 + c8 + e] = v;
            xcb[t_ * 72 + c8 + e] = (bf16_t)(cvt_pk_bf16(v, 0.f) & 0xffffu);
        }
        __syncthreads();
        {
            bf16x8 Af[4][2];
#pragma unroll
            for (int m = 0; m < 4; ++m)
#pragma unroll
                for (int ks = 0; ks < 2; ++ks) Af[m][ks] = *(const LAS bf16x8*)(xcb + (16 * m + fr) * 72 + ks * 32 + fq * 8);
            f32x4 acc[2][4];
#pragma unroll
            for (int gt = 0; gt < 2; ++gt)
#pragma unroll
                for (int m = 0; m < 4; ++m) { acc[gt][m] = (f32x4){0.f, 0.f, 0.f, 0.f};
#pragma unroll
                    for (int ks = 0; ks < 2; ++ks) acc[gt][m] = __builtin_amdgcn_mfma_f32_16x16x32_bf16(Af[m][ks], Bf[gt][ks], acc[gt][m], 0, 0, 0); }
            float At, Ht;
            if (d == 0) lru_epi_scan<0>(acc, brg, big, sp, xcf, Hs, Ps, ch, fq, lane, At, Ht);
            else lru_epi_scan<1>(acc, brg, big, sp, xcf, Hs + 64 * 68, Ps + 64 * 68, ch, fq, lane, At, Ht);
            if (fq == 0) ((f32x2*)(ws + WS_LAGG))[((size_t)(b * LCH + cl) * 2 + d) * 512 + head * 64 + ch] = mk2(At, Ht);
        }
        __syncthreads();
        {
            const int tok = lru_tok(b, cl, t_);
            const float gr[8] = {bf_lo(gv.x), bf_hi(gv.x), bf_lo(gv.y), bf_hi(gv.y), bf_lo(gv.z), bf_hi(gv.z), bf_lo(gv.w), bf_hi(gv.w)};
            float yl[8], gf[8], gb[8];
#pragma unroll
            for (int e = 0; e < 8; ++e) { const float gate = gelu_tanh(gr[e]); const int o = t_ * 68 + c8 + e;
                yl[e] = (Hs[o] + Hs[64 * 68 + o]) * gate; gf[e] = Ps[o] * gate; gb[e] = Ps[64 * 68 + o] * gate; }
            const size_t off = (size_t)tok * 512 + head * 64 + c8;
            u32x4 w; w.x = cvt_pk_bf16(yl[0], yl[1]); w.y = cvt_pk_bf16(yl[2], yl[3]); w.z = cvt_pk_bf16(yl[4], yl[5]); w.w = cvt_pk_bf16(yl[6], yl[7]);
            *(u32x4*)((bf16_t*)(ws + WS_YL) + off) = w;
            w.x = cvt_pk_bf16(gf[0], gf[1]); w.y = cvt_pk_bf16(gf[2], gf[3]); w.z = cvt_pk_bf16(gf[4], gf[5]); w.w = cvt_pk_bf16(gf[6], gf[7]);
            *(u32x4*)((bf16_t*)(ws + WS_GPF) + off) = w;
            w.x = cvt_pk_bf16(gb[0], gb[1]); w.y = cvt_pk_bf16(gb[2], gb[3]); w.z = cvt_pk_bf16(gb[4], gb[5]); w.w = cvt_pk_bf16(gb[6], gb[7]);
            *(u32x4*)((bf16_t*)(ws + WS_GPR) + off) = w;
        }
        U = Un;
    }
    __syncthreads();
}
__device__ void phase_lru_fin(unsigned char* ws) {
    const int tid = fresh_tid(), bid = fresh_bid();
    const float* lh = (const float*)(ws + WS_LHIN);
    for (int item = bid * 512 + tid; item < MTOK * 64; item += (int)gridDim.x * 512) {
        const int tok = item >> 6, c8 = (item & 63) * 8, b = tok / POS, pos = tok % POS;
        const int cl = pos < CTXL ? (pos >> 6) : 4 + ((pos - CTXL) & 63);
        const size_t off = (size_t)tok * 512 + c8;
        const u32x4 yv = *(const u32x4*)((const bf16_t*)(ws + WS_YL) + off), fv = *(const u32x4*)((const bf16_t*)(ws + WS_GPF) + off), rv = *(const u32x4*)((const bf16_t*)(ws + WS_GPR) + off);
        const float* hf = lh + ((size_t)(b * LCH + cl) * 2) * 512 + c8; const float* hr = hf + 512;
        const f32x4 f0 = *(const f32x4*)hf, f1 = *(const f32x4*)(hf + 4), r0 = *(const f32x4*)hr, r1 = *(const f32x4*)(hr + 4);
        u32x4 w;
        w.x = cvt_pk_bf16(bf_lo(yv.x) + bf_lo(fv.x) * f0[0] + bf_lo(rv.x) * r0[0], bf_hi(yv.x) + bf_hi(fv.x) * f0[1] + bf_hi(rv.x) * r0[1]);
        w.y = cvt_pk_bf16(bf_lo(yv.y) + bf_lo(fv.y) * f0[2] + bf_lo(rv.y) * r0[2], bf_hi(yv.y) + bf_hi(fv.y) * f0[3] + bf_hi(rv.y) * r0[3]);
        w.z = cvt_pk_bf16(bf_lo(yv.z) + bf_lo(fv.z) * f1[0] + bf_lo(rv.z) * r1[0], bf_hi(yv.z) + bf_hi(fv.z) * f1[1] + bf_hi(rv.z) * r1[1]);
        w.w = cvt_pk_bf16(bf_lo(yv.w) + bf_lo(fv.w) * f1[2] + bf_lo(rv.w) * r1[2], bf_hi(yv.w) + bf_hi(fv.w) * f1[3] + bf_hi(rv.w) * r1[3]);
        *(u32x4*)((bf16_t*)(ws + WS_R2) + (size_t)tok * 1024 + 512 + c8) = w;
    }
}

__device__ void phase_carry(unsigned char* ws) {
    const int tid = fresh_tid(), bid = fresh_bid();
    const int lane = tid & 63, wid = tid >> 6;
    for (int item = wid * gridDim.x + bid; item < 640; item += 8 * gridDim.x) {
        if (item < 512) {
            const int g = item >> 4, b = (item >> 1) & 7, d = item & 1, n = lane;
            const f32x2 aT = ((const f32x2*)(ws + WS_AT))[(g * 2 + d) * 64 + n];
            const f32x2* hl = (const f32x2*)(ws + WS_HLOC) + ((size_t)(g * MS + b * SCH) * 256 + d * 128 + 2 * n) / 2;
            unsigned* hin = (unsigned*)(ws + WS_US5) + ((size_t)(g * MSP + b * SCH) * K3 + 512 + d * 128 + 2 * n) / 2;
            float hr = 0.f, hi = 0.f;
            for (int ib = 0; ib < SCH / 8; ++ib) {
                f32x2 L[8];
#pragma unroll
                for (int e = 0; e < 8; ++e) { const int i = ib * 8 + e, c = d == 0 ? i : (i < 8 ? 7 - i : 143 - i); L[e] = hl[(size_t)c * 128]; }
#pragma unroll
                for (int e = 0; e < 8; ++e) { const int i = ib * 8 + e, c = d == 0 ? i : (i < 8 ? 7 - i : 143 - i);
                    hin[(size_t)c * (K3 / 2)] = cvt_pk_bf16(hr, hi);
                    const float nr = aT.x * hr - aT.y * hi + L[e].x, ni = aT.x * hi + aT.y * hr + L[e].y; hr = nr; hi = ni; }
            }
        } else {
            const int tl = (item - 512) * 64 + lane, b = tl >> 10, d = (tl >> 9) & 1, ch = tl & 511;
            const f32x2* ag = (const f32x2*)(ws + WS_LAGG) + ((size_t)b * LCH * 2 + d) * 512 + ch;
            float* hin = (float*)(ws + WS_LHIN) + ((size_t)b * LCH * 2 + d) * 512 + ch;
            float H = 0.f;
            for (int ib = 0; ib < LCH / 4; ++ib) {
                f32x2 L[4];
#pragma unroll
                for (int e = 0; e < 4; ++e) { const int i = ib * 4 + e, cl = d == 0 ? i : (i < 4 ? 3 - i : 71 - i); L[e] = ag[(size_t)cl * 1024]; }
#pragma unroll
                for (int e = 0; e < 4; ++e) { const int i = ib * 4 + e, cl = d == 0 ? i : (i < 4 ? 3 - i : 71 - i); hin[(size_t)cl * 1024] = H; H = L[e].x * H + L[e].y; }
            }
        }
    }
}

#define XB_TMO      128
#define XB_XCNT(j)  (256  + 64 * (j))
#define XB_XSUB(j)  (1280 + 64 * (j))
#define XB_XGEN(j)  (2304 + 64 * (j))
#define XB_TOP      3328
#define XB_TOPGEN   3392
#define XCD_BAR_WORDS 3456
#define XB_SPIN_CAP (1u << 22)
__device__ __forceinline__ unsigned xb_ld(unsigned* p)              { return __hip_atomic_load(p, __ATOMIC_RELAXED, __HIP_MEMORY_SCOPE_AGENT); }
__device__ __forceinline__ unsigned xb_add(unsigned* p, unsigned v) { return __hip_atomic_fetch_add(p, v, __ATOMIC_RELAXED, __HIP_MEMORY_SCOPE_AGENT); }
__device__ __forceinline__ unsigned xb_xcc_id() { return (unsigned)__builtin_amdgcn_s_getreg((3 << 11) | 20) & 0xFu; }
#define XB_SPIN(cond, bar) do { unsigned _sp = 0; while (cond) { __builtin_amdgcn_s_sleep(1); \
    if ((++_sp & 255u) == 0u) { if (xb_ld(&(bar)[XB_TMO])) break; if (_sp > XB_SPIN_CAP) { atomicAdd(&(bar)[XB_TMO], 1u); break; } } } } while (0)
__device__ __forceinline__ void xcd_barrier_complete(unsigned* bar, unsigned x, unsigned& nloc, unsigned& nx) {
    const unsigned G = gridDim.x * gridDim.y * gridDim.z;
    unsigned sum, cnt, mine, sp = 0u;
    for (;;) {
        sum = 0u; cnt = 0u; mine = 0u;
#pragma unroll
        for (unsigned j = 0; j < 16; ++j) { const unsigned c = xb_ld(&bar[XB_XCNT(j)]); sum += c; cnt += (c > 0u) ? 1u : 0u; mine = (j == x) ? c : mine; }
        if (sum == G) break;
        __builtin_amdgcn_s_sleep(1);
        if ((++sp & 255u) == 0u) { if (xb_ld(&bar[XB_TMO])) break; if (sp > XB_SPIN_CAP) { atomicAdd(&bar[XB_TMO], 1u); break; } }
    }
    nloc = mine > 0u ? mine : 1u; nx = cnt > 0u ? cnt : 1u;
}
__device__ __forceinline__ void xcd_barrier(unsigned* bar, volatile LAS unsigned* st) {
    asm volatile("s_waitcnt vmcnt(0)" ::: "memory");
    __syncthreads();
    if (threadIdx.x == 0) {
        const unsigned x = xb_xcc_id();
        __builtin_amdgcn_s_waitcnt(0);
        unsigned nloc = st[0], nx = st[1];
        if (nloc == 0u) { xcd_barrier_complete(bar, x, nloc, nx); st[0] = nloc; st[1] = nx; }
        const unsigned old = xb_add(&bar[XB_XSUB(x)], 1u);
        const unsigned gen = old / nloc;
        if (old + 1u == (gen + 1u) * nloc) {
            __builtin_amdgcn_fence(__ATOMIC_RELEASE, "agent");
            asm volatile("s_waitcnt vmcnt(0)" ::: "memory");
            const unsigned og = xb_add(&bar[XB_TOP], 1u);
            const unsigned tg = og / nx;
            if (og + 1u == (tg + 1u) * nx) xb_add(&bar[XB_TOPGEN], 1u);
            else XB_SPIN(xb_ld(&bar[XB_TOPGEN]) == tg, bar);
            __builtin_amdgcn_fence(__ATOMIC_ACQUIRE, "agent");
            xb_add(&bar[XB_XGEN(x)], 1u);
            asm volatile("s_waitcnt vmcnt(0)" ::: "memory");
        } else {
            XB_SPIN(xb_ld(&bar[XB_XGEN(x)]) == gen, bar);
            __builtin_amdgcn_fence(__ATOMIC_ACQUIRE, "agent");
            asm volatile("s_waitcnt vmcnt(0)" ::: "memory");
        }
    }
    __syncthreads();
}

__global__ void __launch_bounds__(512, 2) mega(Args a_unused) {
    extern __shared__ __attribute__((aligned(16))) unsigned char lds_raw[];
    LAS unsigned char* lds = (LAS unsigned char*)lds_raw;
    cg::grid_group grid = cg::this_grid();
    const int G = gridDim.x, c = blockIdx.x;
    volatile LAS unsigned* bst = (volatile LAS unsigned*)(lds + (LDS_BYTES - 16));
    unsigned* const gbar = (unsigned*)(kargs()->ws + WS_BAR);
    if (threadIdx.x == 0) { bst[0] = 0u; bst[1] = 0u; (void)xb_add(&gbar[XB_XCNT(xb_xcc_id())], 1u); }
    __syncthreads();
#define GSYNC() xcd_barrier(gbar, bst)
#define PH_BEGIN KArgP a = kargs(); unsigned char* ws = fresh_ws(); (void)a; (void)ws;

#if PM & 1
    for (int rep = 0; rep < REP_P0; ++rep) {
    { PH_BEGIN for (int g = c; g < NG; g += G) s5tab_group(a, ws, lds, 0, g); }
#endif
#if PM & 2
    { PH_BEGIN phase_mod(a, ws, lds); }
#endif
#if PM & 4
    { PH_BEGIN phase_wconv(a, ws, lds); }
#endif
    }
    grid.sync();
#if PM & 8
    { PH_BEGIN phase_norm<0>(a, ws, 0); }
#endif
    GSYNC();

#pragma unroll 1
    for (int l = 0; l < DEPTH; ++l) {
#if PM & 16
        for (int rep = 0; rep < REP_GEMM; ++rep) { PH_BEGIN unsigned char* wl = ws + WS_WL + (size_t)l * WL_SIZE;
          PlainOrder S; S.init(ws + WS_R2, 1024, wl + WL_IN, 1024, MTOK, DIN, G, c); EpiIn E{(bf16_t*)(ws + WS_US5), (bf16_t*)(ws + WS_XG)};
          gemm_phase<EpiIn, PlainOrder>(lds, 1024, 1024, 1024, S, E); }
#endif
        GSYNC();
#if PM & 32
        for (int rep = 0; rep < REP_GEMM; ++rep) { PH_BEGIN BatchOrder S; S.init(ws + WS_US5, K3, (size_t)MSP * K3 * 2, ws + WS_BT1, K1, (size_t)256 * K1 * 2, MSP / BM, 1, NG, G, c); EpiHloc E{(float*)(ws + WS_HLOC)};
          gemm_phase<EpiHloc, BatchOrder>(lds, K3, K1, K1, S, E); }
#endif
#if PM & 2048
        for (int rep = 0; rep < REP_LRU; ++rep) { PH_BEGIN phase_lru(a, ws, lds, l); }
#endif
        GSYNC();
#if PM & 8192
        for (int rep = 0; rep < REP_CARRY; ++rep) { PH_BEGIN phase_carry(ws); }
#endif
        GSYNC();
#if PM & 64
        for (int rep = 0; rep < REP_GEMM; ++rep) { PH_BEGIN BatchOrder S; S.init(ws + WS_US5, K3, (size_t)MSP * K3 * 2, ws + WS_BT3, K3, (size_t)512 * K3 * 2, MSP / BM, 2, NG, G, c); EpiY1 E{(bf16_t*)(ws + WS_Y1)};
          gemm_phase<EpiY1, BatchOrder>(lds, K3, K3, K3, S, E); }
#endif
#if PM & 4096
        for (int rep = 0; rep < REP_LRU; ++rep) { PH_BEGIN phase_lru_fin(ws); }
#endif
        GSYNC();
#if PM & 128
        for (int rep = 0; rep < REP_GEMM; ++rep) { PH_BEGIN unsigned char* wl = ws + WS_WL + (size_t)l * WL_SIZE;
          PlainOrder S; S.init(ws + WS_Y1, 512, wl + WL_GLU, 512, MTOK, 512, G, c); EpiGlu E{(const bf16_t*)(ws + WS_Y1), (bf16_t*)(ws + WS_R2), a->in[17] + l * 512};
          gemm_phase<EpiGlu, PlainOrder>(lds, 512, 512, 512, S, E); }
#endif
        GSYNC();
#if PM & 256
        for (int rep = 0; rep < REP_GEMM; ++rep) { PH_BEGIN unsigned char* wl = ws + WS_WL + (size_t)l * WL_SIZE;
          PlainOrder S; S.init(ws + WS_R2, 1024, wl + WL_OUT, 1024, MTOK, 1024, G, c); EpiOut E{(bf16_t*)(ws + WS_R3), (float*)(ws + WS_ROWSS)};
          gemm_phase<EpiOut, PlainOrder>(lds, 1024, 1024, 1024, S, E); }
#endif
        GSYNC();
#if PM & 1
        { PH_BEGIN if (l + 1 < DEPTH) for (int g = c; g < NG; g += G) s5tab_group(a, ws, lds, l + 1, g); }
#endif
#if PM & 16384
        { PH_BEGIN phase_norm<1>(a, ws, l); }
#endif
        GSYNC();
#if PM & 512
        for (int rep = 0; rep < REP_GEMM; ++rep) { PH_BEGIN unsigned char* wl = ws + WS_WL + (size_t)l * WL_SIZE;
          PlainOrder S; S.init(ws + WS_R2, 1024, wl + WL_FI, 1024, MTOK, 2 * DFF, G, c); EpiFfn E{(bf16_t*)(ws + WS_AFF)};
          gemm_phase<EpiFfn, PlainOrder>(lds, 1024, 1024, 1024, S, E); }
#endif
        GSYNC();
#if PM & 1024
        for (int rep = 0; rep < REP_GEMM; ++rep) { PH_BEGIN unsigned char* wl = ws + WS_WL + (size_t)l * WL_SIZE;
          PlainOrder S; S.init(ws + WS_AFF, DFF, wl + WL_FO, DFF, MTOK, 1024, G, c); EpiOut E{(bf16_t*)(ws + WS_R3), (float*)(ws + WS_ROWSS)};
          gemm_phase<EpiOut, PlainOrder>(lds, DFF, DFF, DFF, S, E); }
#endif
        GSYNC();
#if PM & 32768
        { PH_BEGIN phase_norm<2>(a, ws, l); }
#endif
        if (l + 1 < DEPTH) GSYNC();
    }
}

extern "C" void kernel_launch(void* const* d_in, const int* in_sizes, int n_in, void* d_out, int out_size, void* d_ws, size_t ws_size, hipStream_t stream) {
    static int grid = 0;
    if (grid == 0) {
        if (n_in != 28 || out_size != NB * SEQ * D || ws_size < WS_END) { fprintf(stderr, "kernel_launch: unexpected shapes (n_in %d, out %d, ws %zu, need %zu)\n", n_in, out_size, ws_size, (size_t)WS_END); grid = -1; return; }
        int dev = 0, cus = 0, per_cu = 0;
        hipGetDevice(&dev); hipDeviceGetAttribute(&cus, hipDeviceAttributeMultiprocessorCount, dev);
        if (hipFuncSetAttribute((const void*)mega, hipFuncAttributeMaxDynamicSharedMemorySize, LDS_BYTES) != hipSuccess) { fprintf(stderr, "kernel_launch: hipFuncSetAttribute failed\n"); grid = -1; return; }
        if (hipOccupancyMaxActiveBlocksPerMultiprocessor(&per_cu, (const void*)mega, 512, LDS_BYTES) != hipSuccess || per_cu < 1) { fprintf(stderr, "kernel_launch: occupancy query says %d\n", per_cu); per_cu = 1; }
        (void)hipGetLastError();
        grid = cus * 1;
        if (grid <= 0) grid = 256;
    }
    if (grid < 0) return;
    if (hipMemsetAsync((char*)d_ws + WS_BAR, 0, 16384, stream) != hipSuccess) { fprintf(stderr, "kernel_launch: memset failed\n"); return; }
    Args a{};
    for (int i = 0; i < 28; ++i) a.in[i] = (const float*)d_in[i];
    a.out = (float*)d_out; a.ws = (unsigned char*)d_ws;
    void* args[] = {&a};
    hipError_t e = hipLaunchCooperativeKernel((const void*)mega, dim3(grid), dim3(512), args, LDS_BYTES, stream);
    if (e != hipSuccess) fprintf(stderr, "kernel_launch: cooperative launch failed: %s (grid %d)\n", hipGetErrorString(e), grid);
}
```

```cpp
#include <hip/hip_runtime.h>
#include <hip/hip_cooperative_groups.h>
#include <cstdio>
namespace cg = cooperative_groups;

#define LAS __attribute__((address_space(3)))
#ifndef PM
#define PM 65535
#endif
#ifndef REP_LRU
#define REP_LRU 1
#endif
#ifndef REP_P0
#define REP_P0 1
#endif
#ifndef REP_CARRY
#define REP_CARRY 1
#endif
#ifndef PROBE_ID
#define PROBE_ID 0
#endif
#define PB(id) const unsigned long long _t0 = (PROBE_ID == (id)) ? __builtin_amdgcn_s_memrealtime() : 0ull;
#define PE(id) if (PROBE_ID == (id)) { const unsigned long long _dt = __builtin_amdgcn_s_memrealtime() - _t0, _t1 = __builtin_amdgcn_s_memrealtime(); while (__builtin_amdgcn_s_memrealtime() - _t1 < 4ull * _dt) __builtin_amdgcn_s_sleep(8); }
#ifndef REP_GEMM
#define REP_GEMM 1
#endif
typedef unsigned short bf16_t;
typedef short bf16x8 __attribute__((ext_vector_type(8)));
typedef float f32x4 __attribute__((ext_vector_type(4)));
typedef unsigned u32x4 __attribute__((ext_vector_type(4)));
typedef float f32x2 __attribute__((ext_vector_type(2)));
typedef unsigned long long __attribute__((address_space(1))) gu64_t;

constexpr int D = 1024, NB = 8, SEQ = 4096, DEPTH = 4, CTXL = 256, POS = CTXL + SEQ, MTOK = NB * POS;
constexpr int DS5 = 512, NG = 32, DLRU = 512, NH = 8, DIN = 1536, DFF = 2816;
constexpr int TS = 32, SCH = POS / TS, MS = NB * SCH, MSP = 1280, K3 = 768, K1 = 512;
constexpr int LCH = 68;
constexpr float EPS = 1e-6f;
constexpr int LDS_BYTES = 147456;

constexpr size_t WS_MOD = 0;
constexpr size_t WS_WL = WS_MOD + 4 * 9 * 6144 * 4;
constexpr size_t WL_IN = 0, WL_GLU = WL_IN + 3145728, WL_OUT = WL_GLU + 524288, WL_FI = WL_OUT + 2097152, WL_FO = WL_FI + 11534336, WL_LRU = WL_FO + 5767168, WL_SIZE = WL_LRU + 262144;
constexpr size_t WS_BT3 = WS_WL + 2 * WL_SIZE;
constexpr size_t WS_BT1 = WS_BT3 + 25165824;
constexpr size_t WS_AT = WS_BT1 + 8388608;
constexpr size_t WS_BIG = WS_AT + 32768;
constexpr size_t WS_US5 = WS_BIG;
constexpr size_t WS_XG = WS_US5 + 62914560;
constexpr size_t WS_HLOC = WS_XG + 71303168;
constexpr size_t WS_Y1 = WS_HLOC + 35651584;
constexpr size_t BIG_SIZE = 205520896;
constexpr size_t WS_AFF = WS_BIG;
constexpr size_t WS_R2 = WS_BIG + BIG_SIZE;
constexpr size_t WS_R3 = WS_R2 + 71303168;
constexpr size_t WS_ROWSS = WS_R3 + 71303168;
constexpr size_t WS_LAGG = WS_ROWSS + 2228224;
constexpr size_t WS_LHIN = WS_LAGG + 4456448;
constexpr size_t WS_YL = WS_R3, WS_GPF = WS_R3 + 35651584;
constexpr size_t WS_BAR = WS_LHIN + 2228224;
constexpr size_t WS_CTR = WS_BAR + 16384;
constexpr size_t WS_XB = WS_CTR + 8192;
constexpr size_t WS_END = WS_XB + 71303168;

struct Args { const float* in[28]; float* out; unsigned char* ws; };
typedef const Args __attribute__((address_space(4)))* KArgP;
__device__ __forceinline__ KArgP kargs() { KArgP p = (KArgP)__builtin_amdgcn_kernarg_segment_ptr(); asm volatile("" : "+s"(p)); return p; }
__device__ __forceinline__ int fresh_tid() { int t = threadIdx.x; asm volatile("" : "+v"(t)); return t; }
__device__ __forceinline__ int fresh_bid() { int t = blockIdx.x; asm volatile("" : "+s"(t)); return t; }
__device__ __forceinline__ unsigned char* fresh_ws() { unsigned char* w = kargs()->ws; asm volatile("" : "+s"(w)); return w; }

__device__ __forceinline__ f32x2 mk2(float x, float y) { f32x2 r; r.x = x; r.y = y; return r; }
__device__ __forceinline__ unsigned cvt_pk_bf16(float lo, float hi) { unsigned r; asm("v_cvt_pk_bf16_f32 %0, %1, %2" : "=v"(r) : "v"(lo), "v"(hi)); return r; }
__device__ __forceinline__ void st16_wt(void* p, u32x4 v) { asm volatile("global_store_dwordx4 %0, %1, off sc1\n\ts_nop 1" :: "v"(p), "v"(v) : "memory"); }
__device__ __forceinline__ void st4_wt(void* p, float v) { asm volatile("global_store_dword %0, %1, off sc1\n\ts_nop 1" :: "v"(p), "v"(v) : "memory"); }
typedef _Float16 h2_t __attribute__((ext_vector_type(2)));
__device__ __forceinline__ unsigned pk_h2(float lo, float hi) { h2_t v; v.x = (_Float16)lo; v.y = (_Float16)hi; return __builtin_bit_cast(unsigned, v); }
__device__ __forceinline__ float h_lo(unsigned w) { const h2_t v = __builtin_bit_cast(h2_t, w); return (float)v.x; }
__device__ __forceinline__ float h_hi(unsigned w) { const h2_t v = __builtin_bit_cast(h2_t, w); return (float)v.y; }
__device__ __forceinline__ float bf_lo(unsigned w) { return __uint_as_float(w << 16); }
__device__ __forceinline__ float bf_hi(unsigned w) { return __uint_as_float(w & 0xffff0000u); }
__device__ __forceinline__ float sigmoidf_(float x) { return __frcp_rn(1.0f + __expf(-x)); }
__device__ __forceinline__ float gelu_tanh(float x) { const float u = 1.5957691216057308f * (x + 0.044715f * x * x * x); return x * __frcp_rn(1.0f + __expf(-u)); }
__device__ __forceinline__ float siluf_(float x) { return x * __frcp_rn(1.0f + __expf(-x)); }

constexpr int BM = 256, BK = 64, HALF = 128, HTB = HALF * BK * 2, NXCD = 8, WGM = 4;
__device__ __forceinline__ int lds_byte(int r, int c) { const int st = (r >> 4) * 2 + (c >> 5), rr = r & 15, cc = c & 31, ob = rr * 64 + cc * 2; return st * 1024 + (ob ^ (((ob >> 9) & 1) << 5)); }
__device__ __forceinline__ void stage_rc(int b, int& R, int& C) { const int st = b / 1024, sb = b % 1024, swz = sb ^ (((sb >> 9) & 1) << 5); R = (st >> 1) * 16 + swz / 64; C = (st & 1) * 32 + (swz % 64) / 2; }
__device__ __forceinline__ int perm32(int rho) { const int n = rho >> 4, i = rho & 15; return 8 * (i >> 2) + 4 * n + (i & 3); }

struct Unit { const char* A; const char* B; int pm, pn, g; };

struct PlainOrder {
    const char* A; const char* B; size_t tA, tB; int nM, nN, nwg, G, c;
    __device__ void init(const void* A_, int lda, const void* B_, int ldb, int M, int N, int G_, int c_, int skipctx = 0) {
        A = (const char*)A_; B = (const char*)B_; tA = (size_t)BM * lda * 2; tB = (size_t)BM * ldb * 2; nM = M / BM; nN = N / BM; if (skipctx) nM = NB * 16; nwg = nM * nN; G = G_; c = c_; }
    __device__ __forceinline__ bool next(int i, Unit& u) const {
        const long L = (long)i * G + c; if (L >= nwg) return false;
        int wgid = (int)L; { const int q = nwg / NXCD, r = nwg % NXCD, xcd = wgid % NXCD, off = wgid / NXCD; wgid = (xcd < r ? xcd * (q + 1) : r * (q + 1) + (xcd - r) * q) + off; }
        const int nig = WGM * nN, gid = wgid / nig, fm = gid * WGM, gsz = (nM - fm) < WGM ? (nM - fm) : WGM;
        u.pm = fm + ((wgid % nig) % gsz); u.pn = (wgid % nig) / gsz; u.g = 0;
        if (nM == NB * 16) u.pm = u.pm + (u.pm >> 4) + 1;
        u.A = A + (size_t)u.pm * tA; u.B = B + (size_t)u.pn * tB; return true;
    }
};
struct BatchOrder {
    const char* A; const char* B; size_t tA, tB, gA, gB; int nM, nN, total, G, c;
    __device__ void init(const void* A_, int lda, size_t gA_, const void* B_, int ldb, size_t gB_, int nM_, int nN_, int ng, int G_, int c_) {
        A = (const char*)A_; B = (const char*)B_; tA = (size_t)BM * lda * 2; tB = (size_t)BM * ldb * 2; gA = gA_; gB = gB_; nM = nM_; nN = nN_; total = nM_ * nN_ * ng; G = G_; c = c_; }
    __device__ __forceinline__ bool next(int i, Unit& u) const {
        const long L = (long)i * G + c; if (L >= total) return false;
        const int per = nM * nN, g = (int)L / per, r = (int)L % per; u.g = g; u.pn = r / nM; u.pm = r % nM;
        u.A = A + (size_t)g * gA + (size_t)u.pm * tA; u.B = B + (size_t)g * gB + (size_t)u.pn * tB; return true;
    }
};

template <class Epi, class Sched>
__device__ __forceinline__ void gemm_phase(LAS unsigned char* lds, const int lda, const int ldb, const int K, const Sched& S, const Epi& E) {
    int tid_ = threadIdx.x; asm volatile("" : "+v"(tid_));
    const int tid = tid_, wid = __builtin_amdgcn_readfirstlane(tid >> 6), lane = tid & 63, wr = wid >> 2, wc = wid & 3, fr = lane & 15, fq = lane >> 4;
    const int nt = K / BK;
    unsigned voffA[2], voffB[2];
#pragma unroll
    for (int i = 0; i < 2; ++i) { int R, C; stage_rc(tid * 16 + i * 8192, R, C); const int Rb = Epi::PERM ? ((R & ~31) + perm32(R & 31)) : R;
        voffA[i] = (unsigned)(R * lda + C) * 2u; voffB[i] = (unsigned)(Rb * ldb + C) * 2u; }
    const size_t kstep = (size_t)(BK * 2);
    const size_t hstepA = (size_t)HALF * lda * 2, hstepB = (size_t)HALF * ldb * 2;
    const unsigned ldsw = (unsigned)wid * 1024u;
    const int aoff = lds_byte(wr * 64 + fr, fq * 8), boff = lds_byte(wc * 32 + fr, fq * 8);
#define PG8_SA(b, h) (((b) * 2 + (h)) * HTB)
#define PG8_SB(b, h) ((4 + (b) * 2 + (h)) * HTB)
#define PG8_STAGE(bufoff, gbase, voff) do { _Pragma("unroll") for (int _i = 0; _i < 2; ++_i) \
        __builtin_amdgcn_global_load_lds((const unsigned*)((const char*)(gbase) + (voff)[_i]), (LAS unsigned*)(lds + (bufoff) + ldsw + _i * 8192), 16, 0, 0); } while (0)
#define PG8_LDA(dst, b, h) do { _Pragma("unroll") for (int m = 0; m < 4; ++m) _Pragma("unroll") for (int k = 0; k < 2; ++k) dst[m][k] = *(const LAS bf16x8*)(lds + PG8_SA(b, h) + aoff + m * 2048 + k * 1024); } while (0)
#define PG8_LDB(dst, b, h) do { _Pragma("unroll") for (int n = 0; n < 2; ++n) _Pragma("unroll") for (int k = 0; k < 2; ++k) dst[n][k] = *(const LAS bf16x8*)(lds + PG8_SB(b, h) + boff + n * 2048 + k * 1024); } while (0)
#define PG8_MMA(ai, bj, At, Bt) do { __builtin_amdgcn_s_setprio(1); _Pragma("unroll") for (int m = 0; m < 4; ++m) _Pragma("unroll") for (int n = 0; n < 2; ++n) _Pragma("unroll") for (int k = 0; k < 2; ++k) \
        acc[ai][bj][m][n] = __builtin_amdgcn_mfma_f32_16x16x32_bf16(Bt[n][k], At[m][k], acc[ai][bj][m][n], 0, 0, 0); __builtin_amdgcn_s_setprio(0); } while (0)
#define PG8_WAIT_V(n) asm volatile("s_waitcnt vmcnt(" #n ")" ::: "memory")
#define PG8_WAIT_L(n) asm volatile("s_waitcnt lgkmcnt(" #n ")" ::: "memory")
#define PG8_BAR __builtin_amdgcn_s_barrier()
#define PG8_SCHED __builtin_amdgcn_sched_barrier(0)
    Unit cur, nxt; int ui = 0;
    if (!S.next(0, cur)) return;
    f32x4 acc[2][2][4][2];
#pragma unroll
    for (int a = 0; a < 2; ++a)
#pragma unroll
        for (int b = 0; b < 2; ++b)
#pragma unroll
            for (int m = 0; m < 4; ++m)
#pragma unroll
                for (int n = 0; n < 2; ++n) acc[a][b][m][n] = (f32x4){0.f, 0.f, 0.f, 0.f};
    bf16x8 At[4][2], B0[2][2], B1[2][2];
    const char* cA = cur.A; const char* cB = cur.B;
    PG8_STAGE(PG8_SB(0, 0), cB, voffB); PG8_STAGE(PG8_SA(0, 0), cA, voffA); PG8_STAGE(PG8_SB(0, 1), cB + hstepB, voffB); PG8_STAGE(PG8_SA(0, 1), cA + hstepA, voffA);
    if (wr == 1) PG8_BAR;
    PG8_WAIT_V(4); PG8_BAR;
    PG8_STAGE(PG8_SB(1, 0), cB + kstep, voffB); PG8_STAGE(PG8_SA(1, 0), cA + kstep, voffA); PG8_STAGE(PG8_SB(1, 1), cB + hstepB + kstep, voffB);
    PG8_WAIT_V(6); PG8_BAR;
    for (;;) {
        const bool has_next = S.next(ui + 1, nxt);
        const char* nA = has_next ? nxt.A : cA; const char* nB = has_next ? nxt.B : cB;
        for (int t = 0; t < nt; t += 2) {
            const bool last = (t == nt - 2);
            const char* a1 = cA + (size_t)(t + 1) * kstep;
            const char* a2 = last ? nA : cA + (size_t)(t + 2) * kstep; const char* b2 = last ? nB : cB + (size_t)(t + 2) * kstep;
            const char* a3 = a2 + kstep; const char* b3 = b2 + kstep;
            PG8_LDB(B0, 0, 0); PG8_SCHED; PG8_LDA(At, 0, 0); PG8_STAGE(PG8_SA(1, 1), a1 + hstepA, voffA);
            PG8_WAIT_L(8); PG8_BAR; PG8_WAIT_L(0); PG8_MMA(0, 0, At, B0); PG8_BAR; PG8_SCHED;
            PG8_LDB(B1, 0, 1); PG8_STAGE(PG8_SB(0, 0), b2, voffB);
            PG8_BAR; PG8_WAIT_L(0); PG8_MMA(0, 1, At, B1); PG8_BAR;
            PG8_LDA(At, 0, 1); PG8_STAGE(PG8_SA(0, 0), a2, voffA);
            PG8_BAR; PG8_WAIT_L(0); PG8_MMA(1, 0, At, B0); PG8_BAR; PG8_SCHED;
            PG8_STAGE(PG8_SB(0, 1), b2 + hstepB, voffB);
            PG8_WAIT_V(6); PG8_BAR; PG8_MMA(1, 1, At, B1); PG8_BAR;
            PG8_LDB(B0, 1, 0); PG8_SCHED; PG8_LDA(At, 1, 0); PG8_STAGE(PG8_SA(0, 1), a2 + hstepA, voffA);
            PG8_WAIT_L(8); PG8_BAR; PG8_WAIT_L(0); PG8_MMA(0, 0, At, B0); PG8_BAR; PG8_SCHED;
            PG8_LDB(B1, 1, 1); PG8_STAGE(PG8_SB(1, 0), b3, voffB);
            PG8_BAR; PG8_WAIT_L(0); PG8_MMA(0, 1, At, B1); PG8_BAR;
            PG8_LDA(At, 1, 1); PG8_STAGE(PG8_SA(1, 0), a3, voffA);
            PG8_BAR; PG8_WAIT_L(0); PG8_MMA(1, 0, At, B0); PG8_BAR; PG8_SCHED;
            PG8_STAGE(PG8_SB(1, 1), b3 + hstepB, voffB);
            PG8_WAIT_V(6); PG8_BAR; PG8_MMA(1, 1, At, B1); PG8_BAR;
        }
        E(acc, cur, wr, wc, fr, fq);
        if (PROBE_ID == 20 && Epi::PROBE2X) { asm volatile("" ::: "memory"); E(acc, cur, wr, wc, fr, fq); }
        if (!has_next) break;
#pragma unroll
        for (int a = 0; a < 2; ++a)
#pragma unroll
            for (int b = 0; b < 2; ++b)
#pragma unroll
                for (int m = 0; m < 4; ++m)
#pragma unroll
                    for (int n = 0; n < 2; ++n) acc[a][b][m][n] = (f32x4){0.f, 0.f, 0.f, 0.f};
        cur = nxt; cA = nA; cB = nB; ++ui;
    }
    PG8_WAIT_V(0);
    if (wr == 0) PG8_BAR;
    PG8_BAR;
#undef PG8_SA
#undef PG8_SB
#undef PG8_STAGE
#undef PG8_LDA
#undef PG8_LDB
#undef PG8_MMA
#undef PG8_WAIT_V
#undef PG8_WAIT_L
#undef PG8_BAR
#undef PG8_SCHED
}

typedef f32x4 AccT[2][2][4][2];

struct EpiIn {
    static constexpr bool PERM = true, PROBE2X = false;
    bf16_t* us5; bf16_t* xg;
    __device__ __forceinline__ void operator()(const AccT& acc, const Unit& u, int wr, int wc, int fr, int fq) const {
#pragma unroll
        for (int ai = 0; ai < 2; ++ai)
#pragma unroll
            for (int m = 0; m < 4; ++m) {
                const int row = u.pm * BM + ai * HALF + wr * 64 + m * 16 + fr;
#pragma unroll
                for (int bj = 0; bj < 2; ++bj) {
                    const int col0 = u.pn * BM + bj * HALF + wc * 32 + 8 * fq;
                    const f32x4 v0 = acc[ai][bj][m][0], v1 = acc[ai][bj][m][1];
                    u32x4 w; w.x = cvt_pk_bf16(v0[0], v0[1]); w.y = cvt_pk_bf16(v0[2], v0[3]); w.z = cvt_pk_bf16(v1[0], v1[1]); w.w = cvt_pk_bf16(v1[2], v1[3]);
                    if (u.pn < 2) { const int g = col0 >> 4, p0 = col0 & 15, mr = row >> 5, s = row & 31;
                        *(u32x4*)(us5 + ((size_t)g * MSP + mr) * K3 + s * 16 + p0) = w; }
                    else *(u32x4*)(xg + (size_t)row * 1024 + (col0 - 512)) = w;
                }
            }
    }
};
struct EpiHloc {
    static constexpr bool PERM = false, PROBE2X = false;
    float* hloc;
    __device__ __forceinline__ void operator()(const AccT& acc, const Unit& u, int wr, int wc, int fr, int fq) const {
#pragma unroll
        for (int ai = 0; ai < 2; ++ai)
#pragma unroll
            for (int m = 0; m < 4; ++m) {
                const int row = u.pm * BM + ai * HALF + wr * 64 + m * 16 + fr;
                if (row < MS) {
                    float* rp = hloc + ((size_t)u.g * MS + row) * 256 + wc * 32 + 4 * fq;
#pragma unroll
                    for (int bj = 0; bj < 2; ++bj)
#pragma unroll
                        for (int n = 0; n < 2; ++n) *(f32x4*)(rp + bj * HALF + n * 16) = acc[ai][bj][m][n];
                }
            }
    }
};
struct EpiY1 {
    static constexpr bool PERM = true, PROBE2X = false;
    bf16_t* y1;
    __device__ __forceinline__ void operator()(const AccT& acc, const Unit& u, int wr, int wc, int fr, int fq) const {
#pragma unroll
        for (int ai = 0; ai < 2; ++ai)
#pragma unroll
            for (int m = 0; m < 4; ++m) {
                const int row = u.pm * BM + ai * HALF + wr * 64 + m * 16 + fr;
                if (row < MS) {
#pragma unroll
                    for (int bj = 0; bj < 2; ++bj) {
                        const int col0 = u.pn * BM + bj * HALF + wc * 32 + 8 * fq, t = col0 >> 4, q0 = col0 & 15;
                        const f32x4 v0 = acc[ai][bj][m][0], v1 = acc[ai][bj][m][1];
                        u32x4 w; w.x = cvt_pk_bf16(gelu_tanh(v0[0]), gelu_tanh(v0[1])); w.y = cvt_pk_bf16(gelu_tanh(v0[2]), gelu_tanh(v0[3]));
                        w.z = cvt_pk_bf16(gelu_tanh(v1[0]), gelu_tanh(v1[1])); w.w = cvt_pk_bf16(gelu_tanh(v1[2]), gelu_tanh(v1[3]));
                        *(u32x4*)(y1 + ((size_t)row * TS + t) * 512 + u.g * 16 + q0) = w;
                    }
                }
            }
    }
};
struct EpiGlu {
    static constexpr bool PERM = true, PROBE2X = false;
    const bf16_t* y1; bf16_t* y; const float* bias;
    __device__ __forceinline__ void operator()(const AccT& acc, const Unit& u, int wr, int wc, int fr, int fq) const {
#pragma unroll
        for (int bj = 0; bj < 2; ++bj) {
            const int col0 = u.pn * BM + bj * HALF + wc * 32 + 8 * fq;
            const f32x4 b0 = *(const f32x4*)(bias + col0), b1 = *(const f32x4*)(bias + col0 + 4);
#pragma unroll
            for (int ai = 0; ai < 2; ++ai)
#pragma unroll
                for (int m = 0; m < 4; ++m) {
                    const int row = u.pm * BM + ai * HALF + wr * 64 + m * 16 + fr;
                    const u32x4 yv = *(const u32x4*)(y1 + (size_t)row * 512 + col0);
                    const f32x4 v0 = acc[ai][bj][m][0] + b0, v1 = acc[ai][bj][m][1] + b1;
                    u32x4 w;
                    w.x = cvt_pk_bf16(bf_lo(yv.x) * sigmoidf_(v0[0]), bf_hi(yv.x) * sigmoidf_(v0[1]));
                    w.y = cvt_pk_bf16(bf_lo(yv.y) * sigmoidf_(v0[2]), bf_hi(yv.y) * sigmoidf_(v0[3]));
                    w.z = cvt_pk_bf16(bf_lo(yv.z) * sigmoidf_(v1[0]), bf_hi(yv.z) * sigmoidf_(v1[1]));
                    w.w = cvt_pk_bf16(bf_lo(yv.w) * sigmoidf_(v1[2]), bf_hi(yv.w) * sigmoidf_(v1[3]));
                    *(u32x4*)(y + (size_t)row * 1024 + col0) = w;
                }
        }
    }
};
struct EpiOut {
    static constexpr bool PERM = true, PROBE2X = false;
    bf16_t* o; float* rowss;
    __device__ __forceinline__ void operator()(const AccT& acc, const Unit& u, int wr, int wc, int fr, int fq) const {
#pragma unroll
        for (int ai = 0; ai < 2; ++ai)
#pragma unroll
            for (int m = 0; m < 4; ++m) {
                const int row = u.pm * BM + ai * HALF + wr * 64 + m * 16 + fr;
                float s = 0.f;
#pragma unroll
                for (int bj = 0; bj < 2; ++bj) {
                    const int col0 = u.pn * BM + bj * HALF + wc * 32 + 8 * fq;
                    const f32x4 v0 = acc[ai][bj][m][0], v1 = acc[ai][bj][m][1];
                    s += (v0[0] * v0[0] + v0[1] * v0[1]) + (v0[2] * v0[2] + v0[3] * v0[3]) + (v1[0] * v1[0] + v1[1] * v1[1]) + (v1[2] * v1[2] + v1[3] * v1[3]);
                    u32x4 w; w.x = cvt_pk_bf16(v0[0], v0[1]); w.y = cvt_pk_bf16(v0[2], v0[3]); w.z = cvt_pk_bf16(v1[0], v1[1]); w.w = cvt_pk_bf16(v1[2], v1[3]);
                    *(u32x4*)(o + (size_t)row * 1024 + col0) = w;
                }
                s += __shfl_xor(s, 16); s += __shfl_xor(s, 32);
                if (fq == 0) rowss[(size_t)row * 16 + u.pn * 4 + wc] = s;
            }
    }
};
struct EpiOutPub {
    static constexpr bool PERM = true, PROBE2X = false;
    bf16_t* o; float* rowss; unsigned* cnt;
    __device__ __forceinline__ void operator()(const AccT& acc, const Unit& u, int wr, int wc, int fr, int fq) const {
#pragma unroll
        for (int ai = 0; ai < 2; ++ai)
#pragma unroll
            for (int m = 0; m < 4; ++m) {
                const int row = u.pm * BM + ai * HALF + wr * 64 + m * 16 + fr;
#pragma unroll
                for (int bj = 0; bj < 2; ++bj) {
                    const int col0 = u.pn * BM + bj * HALF + wc * 32 + 8 * fq;
                    const f32x4 v0 = acc[ai][bj][m][0], v1 = acc[ai][bj][m][1];
                    u32x4 w; w.x = cvt_pk_bf16(v0[0], v0[1]); w.y = cvt_pk_bf16(v0[2], v0[3]); w.z = cvt_pk_bf16(v1[0], v1[1]); w.w = cvt_pk_bf16(v1[2], v1[3]);
                    st16_wt(o + (size_t)row * 1024 + col0, w);
                }
            }
        asm volatile("s_waitcnt vmcnt(0)" ::: "memory");
        if (fr == 0 && fq == 0) (void)__hip_atomic_fetch_add(cnt + u.pm, 1u, __ATOMIC_RELAXED, __HIP_MEMORY_SCOPE_AGENT);
    }
};
struct PanelOrder {
    const char* A; const char* B; size_t tA, tB; int np, G, c, skip;
    __device__ void init(const void* A_, int lda, const void* B_, int ldb, int G_, int c_, int skipctx) {
        A = (const char*)A_; B = (const char*)B_; tA = (size_t)BM * lda * 2; tB = (size_t)BM * ldb * 2; skip = skipctx; np = skipctx ? NB * 16 : MTOK / BM; G = G_; c = c_; }
    __device__ __forceinline__ int panel(int p) const { return skip ? p + (p >> 4) + 1 : p; }
    __device__ __forceinline__ bool next(int i, Unit& u) const {
        int p, pn;
        if (G == 256) {
            const int x = c & 7, j = c >> 3, rem = np - i * 64; if (rem <= 0) return false;
            const int ppx = rem >= 64 ? 8 : (rem + 7) >> 3;
            if ((j >> 2) >= ppx) return false;
            p = i * 64 + x * ppx + (j >> 2); pn = j & 3; if (p >= np) return false;
        } else { const long L = (long)i * G + c; if (L >= (long)np * 4) return false; p = (int)L >> 2; pn = (int)L & 3; }
        u.pm = panel(p); u.pn = pn; u.g = 0;
        u.A = A + (size_t)u.pm * tA; u.B = B + (size_t)u.pn * tB; return true;
    }
};
struct EpiFfn {
    static constexpr bool PERM = true, PROBE2X = true;
    bf16_t* aff;
    __device__ __forceinline__ void operator()(const AccT& acc, const Unit& u, int wr, int wc, int fr, int fq) const {
#pragma unroll
        for (int ai = 0; ai < 2; ++ai)
#pragma unroll
            for (int m = 0; m < 4; ++m) {
                const int row = u.pm * BM + ai * HALF + wr * 64 + m * 16 + fr;
                const f32x4 g0 = acc[ai][0][m][0], g1 = acc[ai][0][m][1], u0 = acc[ai][1][m][0], u1 = acc[ai][1][m][1];
                u32x4 w;
                w.x = cvt_pk_bf16(siluf_(g0[0]) * u0[0], siluf_(g0[1]) * u0[1]); w.y = cvt_pk_bf16(siluf_(g0[2]) * u0[2], siluf_(g0[3]) * u0[3]);
                w.z = cvt_pk_bf16(siluf_(g1[0]) * u1[0], siluf_(g1[1]) * u1[1]); w.w = cvt_pk_bf16(siluf_(g1[2]) * u1[2], siluf_(g1[3]) * u1[3]);
                *(u32x4*)(aff + (size_t)row * DFF + u.pn * 128 + wc * 32 + 8 * fq) = w;
            }
    }
};

__device__ __forceinline__ void phase_mod(KArgP a, unsigned char* ws, LAS unsigned char* lds, int first, int step) {
    const int tid = fresh_tid(), lane = tid & 63, wv = tid >> 6;
    LAS float* sc = (LAS float*)lds;
    LAS float* red = sc + 9216;
    for (int idx = tid; idx < 9216; idx += 512) { const int bb = idx >> 10, k = idx & 1023; const float v = bb < 8 ? a->in[1][bb * 1024 + k] : a->in[3][k]; sc[idx] = siluf_(v); }
    __syncthreads();
    float* mod = (float*)(ws + WS_MOD);
    for (int u = first; u < 384; u += step) {
        const int l = u / 96, jg = u % 96, j = jg * 64 + lane;
        const float* w = a->in[4] + ((size_t)l * 1024 + wv * 128) * 6144 + j;
        float acc[9];
#pragma unroll
        for (int bb = 0; bb < 9; ++bb) acc[bb] = 0.f;
        for (int k0 = 0; k0 < 128; k0 += 16) {
            float wv8[16];
#pragma unroll
            for (int e = 0; e < 16; ++e) wv8[e] = __builtin_nontemporal_load(w + (size_t)(k0 + e) * 6144);
#pragma unroll
            for (int e = 0; e < 16; ++e)
#pragma unroll
                for (int bb = 0; bb < 9; ++bb) acc[bb] += sc[bb * 1024 + wv * 128 + k0 + e] * wv8[e];
        }
#pragma unroll
        for (int bb = 0; bb < 9; ++bb) red[(wv * 9 + bb) * 64 + lane] = acc[bb];
        __syncthreads();
        for (int o = tid; o < 576; o += 512) { const int bb = o >> 6, ln = o & 63; float s = a->in[5][l * 6144 + jg * 64 + ln];
#pragma unroll
            for (int w8 = 0; w8 < 8; ++w8) s += red[(w8 * 9 + bb) * 64 + ln];
            mod[((size_t)l * 9 + bb) * 6144 + jg * 64 + ln] = s; }
        __syncthreads();
    }
}

__device__ __forceinline__ void transpose_tile(const float* src, int N, bf16_t* dst, int Kd, int k0, int n0, int drow0, LAS float* t) {
    const int tid = fresh_tid();
#pragma unroll
    for (int i = 0; i < 16; ++i) { const int k = i * 8 + (tid >> 6), n = tid & 63; t[k * 65 + n] = src[(size_t)(k0 + k) * N + n0 + n]; }
    __syncthreads();
#pragma unroll
    for (int i = 0; i < 8; ++i) { const int n = i * 8 + (tid >> 6), kk = (tid & 63) * 2;
        *(unsigned*)(dst + (size_t)(drow0 + n) * Kd + k0 + kk) = cvt_pk_bf16(t[kk * 65 + n], t[(kk + 1) * 65 + n]); }
    __syncthreads();
}
__device__ __forceinline__ void phase_wconv(KArgP a, unsigned char* ws, LAS unsigned char* lds, int l, int first, int step) {
    LAS float* t = (LAS float*)lds;
    for (int T = first; T < 1408; T += step) {
        int r = T;
        unsigned char* wl = ws + WS_WL + (size_t)(l & 1) * WL_SIZE;
        if (r < 192) { const int kt = r / 24, nt = r % 24; transpose_tile(a->in[7] + (size_t)l * 1024 * 1536, 1536, (bf16_t*)(wl + WL_IN), 1024, kt * 128, nt * 64, nt * 64, t); }
        else if (r < 224) { r -= 192; const int kt = r / 8, nt = r % 8; transpose_tile(a->in[16] + (size_t)l * 512 * 512, 512, (bf16_t*)(wl + WL_GLU), 512, kt * 128, nt * 64, nt * 64, t); }
        else if (r < 352) { r -= 224; const int kt = r / 16, nt = r % 16; transpose_tile(a->in[25] + (size_t)l * 1024 * 1024, 1024, (bf16_t*)(wl + WL_OUT), 1024, kt * 128, nt * 64, nt * 64, t); }
        else if (r < 1056) { r -= 352; const int kt = r / 88, nt = r % 88; const int n0 = nt * 64;
            const int drow0 = n0 < DFF ? 256 * (n0 / 128) + (n0 % 128) : 256 * ((n0 - DFF) / 128) + 128 + ((n0 - DFF) % 128);
            transpose_tile(a->in[26] + (size_t)l * 1024 * 5632, 5632, (bf16_t*)(wl + WL_FI), 1024, kt * 128, n0, drow0, t); }
        else { r -= 1056; const int kt = r / 16, nt = r % 16; transpose_tile(a->in[27] + (size_t)l * DFF * 1024, 1024, (bf16_t*)(wl + WL_FO), DFF, kt * 128, nt * 64, nt * 64, t); }
    }
    for (int idx = first * 512 + fresh_tid(); idx < 8 * 4 * 64 * 64; idx += step * 512) {
        const int j = idx & 63, k = (idx >> 6) & 63, nb = (idx >> 12) & 3, h = (idx >> 14) & 7;
        const float* src = (nb & 1) ? a->in[22] : a->in[20];
        const float v = src[((((size_t)l * 2 + (nb >> 1)) * 8 + h) * 64 + k) * 64 + j];
        bf16_t* dst = (bf16_t*)(ws + WS_WL + (size_t)(l & 1) * WL_SIZE + WL_LRU);
        dst[((size_t)h * 256 + nb * 64 + j) * 64 + k] = (bf16_t)(cvt_pk_bf16(v, 0.f) & 0xffffu);
    }
}

__device__ __forceinline__ void s5tab_group(KArgP a, unsigned char* ws, LAS unsigned char* lds, int layer, int g) {
    const int tid = fresh_tid();
    LAS f32x2* abp = (LAS f32x2*)lds;
    LAS f32x2* bbv = (LAS f32x2*)(lds + 33792);
    LAS f32x2* ccv = (LAS f32x2*)(lds + 50176);
    LAS float* kt = (LAS float*)(lds + 67584);
    LAS float* dl = (LAS float*)(lds + 133120);
    if (tid < 16) dl[tid] = a->in[15][layer * 512 + g * 16 + tid];
    {
        const int d = tid >> 8, n = (tid >> 2) & 63, jq = tid & 3, base = (layer * 2 + d) * 32 + g;
        const float dt = expf(a->in[10][base]);
        const float are = a->in[8][base * 64 + n], aim = a->in[9][base * 64 + n];
        const float zr = are * dt; float rev = aim * dt * 0.15915494309189535f; rev -= rintf(rev); const float zi = rev * 6.283185307179586f;
        const float em1 = expm1f(zr), cz = cosf(zi), sz = sinf(zi), s2 = sinf(0.5f * zi);
        const float a1r = (em1 + 1.f) * cz, a1i = (em1 + 1.f) * sz;
        float t2r = a1r * a1r - a1i * a1i, t2i = 2.f * a1r * a1i;
        float t4r = t2r * t2r - t2i * t2i, t4i = 2.f * t2r * t2i;
        const float a8r = t4r * t4r - t4i * t4i, a8i = 2.f * t4r * t4i;
        float pr = 1.f, pi = 0.f;
        for (int k = 0; k < jq; ++k) { const float nr_ = pr * a8r - pi * a8i, ni_ = pr * a8i + pi * a8r; pr = nr_; pi = ni_; }
        if (jq == 0) { float o1 = 1.f, o0 = 0.f; asm volatile("" : "+v"(o1), "+v"(o0)); abp[(d * 64 + n) * 33] = mk2(o1, o0); }
#pragma unroll
        for (int k = 1; k <= 8; ++k) { const float nr_ = pr * a1r - pi * a1i, ni_ = pr * a1i + pi * a1r; pr = nr_; pi = ni_; abp[(d * 64 + n) * 33 + 8 * jq + k] = mk2(pr, pi); }
        if (jq == 3) ((f32x2*)(ws + WS_AT))[(g * 2 + d) * 64 + n] = mk2(pr, pi);
        const float nr = em1 * cz - 2.f * s2 * s2, abim = a1i;
        const float den = are * are + aim * aim;
        const float fre = (nr * are + abim * aim) / den, fim = (abim * are - nr * aim) / den;
#pragma unroll
        for (int pp = 0; pp < 4; ++pp) { const int p = jq * 4 + pp;
            const float br = a->in[11][((size_t)base * 64 + n) * 16 + p], bi = a->in[12][((size_t)base * 64 + n) * 16 + p];
            bbv[(d * 64 + n) * 16 + p] = mk2(fre * br - fim * bi, fre * bi + fim * br);
            ccv[(d * 64 + n) * 17 + p] = mk2(a->in[13][((size_t)base * 16 + p) * 64 + n], a->in[14][((size_t)base * 16 + p) * 64 + n]); }
    }
    __syncthreads();
    for (int it = 0; it < 2; ++it) {
        const int combo = tid + it * 512, d = combo >> 9, tau = (combo >> 4) & 31, q = combo & 15;
        float acc[16];
#pragma unroll
        for (int p = 0; p < 16; ++p) acc[p] = 0.f;
        for (int n = 0; n < 64; ++n) {
            const f32x2 c = ccv[(d * 64 + n) * 17 + q], pw = abp[(d * 64 + n) * 33 + tau];
            const float wr_ = c.x * pw.x - c.y * pw.y, wi_ = c.x * pw.y + c.y * pw.x;
#pragma unroll
            for (int p = 0; p < 16; p += 2) { const f32x4 bv = *(const LAS f32x4*)(bbv + (d * 64 + n) * 16 + p); acc[p] += wr_ * bv[0] - wi_ * bv[1]; acc[p + 1] += wr_ * bv[2] - wi_ * bv[3]; }
        }
#pragma unroll
        for (int p4 = 0; p4 < 4; ++p4) *(LAS f32x4*)(kt + (((d * 16 + q) * 2 + (p4 >> 1)) * 32 + tau) * 8 + (p4 & 1) * 4) = (f32x4){acc[4 * p4], acc[4 * p4 + 1], acc[4 * p4 + 2], acc[4 * p4 + 3]};
    }
    __syncthreads();
    bf16_t* bt3 = (bf16_t*)(ws + WS_BT3) + (size_t)g * 512 * K3;
    bf16_t* bt1 = (bf16_t*)(ws + WS_BT1) + (size_t)g * 256 * K1;
    for (int i = 0; i < 64; ++i) {
        const int it = tid + 512 * i, row = it >> 6, sidx = (it >> 1) & 31, ph = it & 1, t = row >> 4, q = row & 15;
        const int tf = t - sidx, tr = sidx - t;
        const float mf = tf >= 0 ? 1.f : 0.f, mr = tr >= 0 ? 1.f : 0.f;
        const LAS float* pf = kt + ((q * 2 + ph) * 32 + (tf >= 0 ? tf : 0)) * 8;
        const LAS float* pr_ = kt + (((16 + q) * 2 + ph) * 32 + (tr >= 0 ? tr : 0)) * 8;
        const f32x4 f0 = *(const LAS f32x4*)pf, f1 = *(const LAS f32x4*)(pf + 4), r0 = *(const LAS f32x4*)pr_, r1 = *(const LAS f32x4*)(pr_ + 4);
        const float dq = (sidx == t) ? dl[q] : 0.f; const int qe = q - ph * 8;
        float v[8];
#pragma unroll
        for (int e = 0; e < 4; ++e) { v[e] = mf * f0[e] + mr * r0[e] + (qe == e ? dq : 0.f); v[4 + e] = mf * f1[e] + mr * r1[e] + (qe == 4 + e ? dq : 0.f); }
        u32x4 w; w.x = cvt_pk_bf16(v[0], v[1]); w.y = cvt_pk_bf16(v[2], v[3]); w.z = cvt_pk_bf16(v[4], v[5]); w.w = cvt_pk_bf16(v[6], v[7]);
        *(u32x4*)(bt3 + (size_t)row * K3 + sidx * 16 + ph * 8) = w;
    }
    for (int i = 0; i < 32; ++i) {
        const int it = tid + 512 * i, row = it >> 5, c8 = (it & 31) * 8, t = row >> 4, q = row & 15, d = c8 >> 7, n0 = (c8 & 127) >> 1;
        const int pw = d == 0 ? t + 1 : 32 - t;
        float v[8];
#pragma unroll
        for (int e = 0; e < 4; ++e) { const f32x2 c = ccv[(d * 64 + n0 + e) * 17 + q], pa = abp[(d * 64 + n0 + e) * 33 + pw];
            v[2 * e] = c.x * pa.x - c.y * pa.y; v[2 * e + 1] = -(c.x * pa.y + c.y * pa.x); }
        u32x4 w; w.x = cvt_pk_bf16(v[0], v[1]); w.y = cvt_pk_bf16(v[2], v[3]); w.z = cvt_pk_bf16(v[4], v[5]); w.w = cvt_pk_bf16(v[6], v[7]);
        *(u32x4*)(bt3 + (size_t)row * K3 + 512 + c8) = w;
    }
    for (int i = 0; i < 32; ++i) {
        const int it = tid + 512 * i, row = it >> 6, k8 = (it & 63) * 8, s = k8 >> 4, p0 = k8 & 15, d = row >> 7, n = (row & 127) >> 1, ci = row & 1;
        const int pw = d == 0 ? 31 - s : s;
        const f32x2 pa = abp[(d * 64 + n) * 33 + pw];
        float v[8];
#pragma unroll
        for (int e = 0; e < 8; ++e) { const f32x2 bv = bbv[(d * 64 + n) * 16 + p0 + e]; v[e] = ci ? (pa.x * bv.y + pa.y * bv.x) : (pa.x * bv.x - pa.y * bv.y); }
        u32x4 w; w.x = cvt_pk_bf16(v[0], v[1]); w.y = cvt_pk_bf16(v[2], v[3]); w.z = cvt_pk_bf16(v[4], v[5]); w.w = cvt_pk_bf16(v[6], v[7]);
        *(u32x4*)(bt1 + (size_t)row * K1 + k8) = w;
    }
    __syncthreads();
}

template <int MODE, int NR, bool COH = false>
__device__ __forceinline__ void norm_rows(KArgP a, unsigned char* ws, int layer, int R0, int lane, const float (&cA)[16], const float (&cB)[16], const float (&cC)[16]) {
    const bool from_input = (MODE == 0) || (MODE == 1 && layer == 0);
    const bool final_out = (MODE == 2 && layer == DEPTH - 1);
    float x[NR][16]; u32x4 ov[NR][2]; float rsv[NR]; float* fdst[NR];
#pragma unroll
    for (int r = 0; r < NR; ++r) {
        const int R = R0 + r, b = R / POS, pos = R % POS; const bool isctx = pos < CTXL;
        fdst[r] = a->out + ((size_t)b * SEQ + (isctx ? 0 : pos - CTXL)) * D;
        if (from_input) {
            const float* xsrc = isctx ? a->in[2] + ((size_t)b * CTXL + pos) * D : a->in[0] + ((size_t)b * SEQ + (pos - CTXL)) * D;
#pragma unroll
            for (int i = 0; i < 2; ++i) { const int c0 = lane * 8 + 512 * i; const f32x4 p = *(const f32x4*)(xsrc + c0), q = *(const f32x4*)(xsrc + c0 + 4);
                x[r][8 * i + 0] = p[0]; x[r][8 * i + 1] = p[1]; x[r][8 * i + 2] = p[2]; x[r][8 * i + 3] = p[3]; x[r][8 * i + 4] = q[0]; x[r][8 * i + 5] = q[1]; x[r][8 * i + 6] = q[2]; x[r][8 * i + 7] = q[3]; }
        } else {
            const bf16_t* xb = (const bf16_t*)(ws + WS_XB) + (size_t)R * D;
#pragma unroll
            for (int i = 0; i < 2; ++i) { const u32x4 v = *(const u32x4*)(xb + lane * 8 + 512 * i);
                x[r][8 * i + 0] = h_lo(v.x); x[r][8 * i + 1] = h_hi(v.x); x[r][8 * i + 2] = h_lo(v.y); x[r][8 * i + 3] = h_hi(v.y); x[r][8 * i + 4] = h_lo(v.z); x[r][8 * i + 5] = h_hi(v.z); x[r][8 * i + 6] = h_lo(v.w); x[r][8 * i + 7] = h_hi(v.w); }
        }
        if (MODE != 0) {
            const bf16_t* o = (const bf16_t*)(ws + WS_R3) + (size_t)R * D;
            if (COH) {
                unsigned long long q[4];
#pragma unroll
                for (int k = 0; k < 4; ++k) q[k] = __hip_atomic_load((gu64_t*)(o + lane * 8 + 512 * (k >> 1) + 4 * (k & 1)), __ATOMIC_RELAXED, __HIP_MEMORY_SCOPE_AGENT);
                ov[r][0] = (u32x4){(unsigned)q[0], (unsigned)(q[0] >> 32), (unsigned)q[1], (unsigned)(q[1] >> 32)};
                ov[r][1] = (u32x4){(unsigned)q[2], (unsigned)(q[2] >> 32), (unsigned)q[3], (unsigned)(q[3] >> 32)};
                rsv[r] = 0.f;
            } else {
            ov[r][0] = *(const u32x4*)(o + lane * 8); ov[r][1] = *(const u32x4*)(o + lane * 8 + 512);
            rsv[r] = ((const float*)(ws + WS_ROWSS))[(size_t)R * 16 + (lane & 15)]; }
        }
    }
#pragma unroll
    for (int r = 0; r < NR; ++r) {
        if (MODE != 0) {
            float ofa[2][8];
#pragma unroll
            for (int i = 0; i < 2; ++i) { const u32x4 v = ov[r][i];
                ofa[i][0] = bf_lo(v.x); ofa[i][1] = bf_hi(v.x); ofa[i][2] = bf_lo(v.y); ofa[i][3] = bf_hi(v.y); ofa[i][4] = bf_lo(v.z); ofa[i][5] = bf_hi(v.z); ofa[i][6] = bf_lo(v.w); ofa[i][7] = bf_hi(v.w); }
            float ss;
            if (COH) {
                ss = 0.f;
#pragma unroll
                for (int i = 0; i < 2; ++i)
#pragma unroll
                    for (int e = 0; e < 8; ++e) ss += ofa[i][e] * ofa[i][e];
#pragma unroll
                for (int off = 32; off >= 1; off >>= 1) ss += __shfl_xor(ss, off);
            } else { ss = rsv[r]; ss += __shfl_xor(ss, 1); ss += __shfl_xor(ss, 2); ss += __shfl_xor(ss, 4); ss += __shfl_xor(ss, 8); }
            const float rstd = rsqrtf(ss * (1.0f / 1024.0f) + EPS);
#pragma unroll
            for (int i = 0; i < 2; ++i) { const float (&of)[8] = ofa[i];
#pragma unroll
                for (int e = 0; e < 8; ++e) x[r][8 * i + e] += cA[8 * i + e] * (of[e] * rstd);
                const int c0 = lane * 8 + 512 * i;
                if (final_out) { *(f32x4*)(fdst[r] + c0) = (f32x4){x[r][8 * i], x[r][8 * i + 1], x[r][8 * i + 2], x[r][8 * i + 3]}; *(f32x4*)(fdst[r] + c0 + 4) = (f32x4){x[r][8 * i + 4], x[r][8 * i + 5], x[r][8 * i + 6], x[r][8 * i + 7]}; }
                else { u32x4 w; w.x = pk_h2(x[r][8 * i], x[r][8 * i + 1]); w.y = pk_h2(x[r][8 * i + 2], x[r][8 * i + 3]); w.z = pk_h2(x[r][8 * i + 4], x[r][8 * i + 5]); w.w = pk_h2(x[r][8 * i + 6], x[r][8 * i + 7]);
                    *(u32x4*)((bf16_t*)(ws + WS_XB) + (size_t)(R0 + r) * D + c0) = w; } }
        }
        if (!(MODE == 2 && layer == DEPTH - 1)) {
            float s2 = 0.f;
#pragma unroll
            for (int e = 0; e < 16; ++e) s2 += x[r][e] * x[r][e];
#pragma unroll
            for (int off = 32; off >= 1; off >>= 1) s2 += __shfl_xor(s2, off);
            const float rstd2 = rsqrtf(s2 * (1.0f / 1024.0f) + EPS);
            bf16_t* h = (bf16_t*)(ws + WS_R2) + (size_t)(R0 + r) * D;
#pragma unroll
            for (int i = 0; i < 2; ++i) { float hv[8];
#pragma unroll
                for (int e = 0; e < 8; ++e) hv[e] = (x[r][8 * i + e] * rstd2) * cB[8 * i + e] + cC[8 * i + e];
                u32x4 w; w.x = cvt_pk_bf16(hv[0], hv[1]); w.y = cvt_pk_bf16(hv[2], hv[3]); w.z = cvt_pk_bf16(hv[4], hv[5]); w.w = cvt_pk_bf16(hv[6], hv[7]);
                *(u32x4*)(h + lane * 8 + 512 * i) = w; }
        }
    }
}
template <int MODE>
__device__ __forceinline__ void norm_params(KArgP a, unsigned char* ws, int layer, int cb, int lane, float (&cA)[16], float (&cB)[16], float (&cC)[16]) {
    const float* mod = (const float*)(ws + WS_MOD);
    const float* gains = a->in[6];
    const int ln = MODE == 2 ? layer + 1 : layer;
    const float* gate = mod + ((size_t)layer * 9 + cb) * 6144 + (MODE == 1 ? 2 : 5) * 1024;
    const float* gpost = gains + ((size_t)layer * 4 + (MODE == 1 ? 1 : 3)) * 1024;
    const float* gpre = gains + ((size_t)(ln < DEPTH ? ln : 0) * 4 + (MODE == 1 ? 2 : 0)) * 1024;
    const float* shp = mod + ((size_t)(ln < DEPTH ? ln : 0) * 9 + cb) * 6144 + (MODE == 1 ? 3 : 0) * 1024;
    const float* scp = shp + 1024;
#pragma unroll
    for (int i = 0; i < 2; ++i)
#pragma unroll
        for (int e = 0; e < 8; ++e) { const int c = lane * 8 + 512 * i + e;
            if (MODE != 0) cA[8 * i + e] = gate[c] * gpost[c];
            cB[8 * i + e] = gpre[c] * (1.f + scp[c]); cC[8 * i + e] = shp[c]; }
}
template <int MODE>
__device__ __forceinline__ void phase_norm(KArgP a, unsigned char* ws, int layer) {
    const int tid = fresh_tid();
    const int lane = tid & 63, wid = tid >> 6;
    const int gw = fresh_bid() * 8 + wid, GW = gridDim.x * 8;
    const float* mod = (const float*)(ws + WS_MOD);
    const float* gains = a->in[6];
    const int rpw = (MTOK + GW - 1) / GW;
    int R = gw * rpw; const int Rend = (R + rpw) < MTOK ? (R + rpw) : MTOK;
    int cur_cb = -1;
    float cA[16], cB[16], cC[16];
#pragma unroll
    for (int e = 0; e < 16; ++e) { cA[e] = 0.f; cB[e] = 0.f; cC[e] = 0.f; }
    while (R < Rend) {
        const int b = R / POS, pos = R % POS, cb = pos < CTXL ? 8 : b;
        int n = Rend - R; if (n > 4) n = 4;
        { const int Rl = R + n - 1, bl = Rl / POS, pl = Rl % POS, cbl = pl < CTXL ? 8 : bl; if (cbl != cb) n = 1; }
        if (MODE != 0 && layer == DEPTH - 1 && cb == 8) { R += n; continue; }
        if (cb != cur_cb) {
            cur_cb = cb;
            const int ln = MODE == 2 ? layer + 1 : layer;
            const float* gate = mod + ((size_t)layer * 9 + cb) * 6144 + (MODE == 1 ? 2 : 5) * 1024;
            const float* gpost = gains + ((size_t)layer * 4 + (MODE == 1 ? 1 : 3)) * 1024;
            const float* gpre = gains + ((size_t)(ln < DEPTH ? ln : 0) * 4 + (MODE == 1 ? 2 : 0)) * 1024;
            const float* shp = mod + ((size_t)(ln < DEPTH ? ln : 0) * 9 + cb) * 6144 + (MODE == 1 ? 3 : 0) * 1024;
            const float* scp = shp + 1024;
#pragma unroll
            for (int i = 0; i < 2; ++i)
#pragma unroll
                for (int e = 0; e < 8; ++e) { const int c = lane * 8 + 512 * i + e;
                    if (MODE != 0) cA[8 * i + e] = gate[c] * gpost[c];
                    cB[8 * i + e] = gpre[c] * (1.f + scp[c]); cC[8 * i + e] = shp[c]; }
        }
        if (n == 4) { norm_rows<MODE, 4>(a, ws, layer, R, lane, cA, cB, cC); R += 4; }
        else { norm_rows<MODE, 1>(a, ws, layer, R, lane, cA, cB, cC); R += 1; }
    }
}

template <int MODE>
__device__ __forceinline__ void norm_tasks(KArgP a, unsigned char* ws, LAS unsigned char* lds, int layer, unsigned* ctr, int skipctx) {
    const int tid = fresh_tid(), lane = tid & 63, wid = tid >> 6;
    volatile LAS unsigned* tq = (volatile LAS unsigned*)lds;
    const unsigned ntask = (skipctx ? NB * 16 : MTOK / BM) * 4;
    float cA[16], cB[16], cC[16];
#pragma unroll
    for (int e = 0; e < 16; ++e) { cA[e] = 0.f; cB[e] = 0.f; cC[e] = 0.f; }
    int cur_cb = -1;
    for (;;) {
        __syncthreads();
        if (tid == 0) {
            const unsigned t = __hip_atomic_fetch_add(ctr + 200, 1u, __ATOMIC_RELAXED, __HIP_MEMORY_SCOPE_AGENT);
            if (t < ntask) {
                const int p = (int)(t >> 2), pm = skipctx ? p + (p >> 4) + 1 : p;
                unsigned sp = 0;
                while (__hip_atomic_load(ctr + pm, __ATOMIC_RELAXED, __HIP_MEMORY_SCOPE_AGENT) < 32u) { __builtin_amdgcn_s_sleep(2); if (++sp > (1u << 24)) break; }
            }
            tq[0] = t;
        }
        __syncthreads();
        const unsigned t = tq[0];
        if (t >= ntask) break;
        const int p = (int)(t >> 2), pm = skipctx ? p + (p >> 4) + 1 : p;
        const int b = pm / 17, cb = (pm % 17 == 0) ? 8 : b;
        if (cb != cur_cb) { cur_cb = cb; norm_params<MODE>(a, ws, layer, cb, lane, cA, cB, cC); }
        const int R0 = pm * BM + (int)(t & 3) * 64 + wid * 8;
        norm_rows<MODE, 4, true>(a, ws, layer, R0, lane, cA, cB, cC);
        norm_rows<MODE, 4, true>(a, ws, layer, R0 + 4, lane, cA, cB, cC);
    }
    __syncthreads();
}

__device__ __forceinline__ int lru_tok(int b, int cl, int j) {
    if (cl < 4) { const int p = cl * 64 + j; return (p >= 0 && p < CTXL) ? b * POS + p : -1; }
    const int jj = (cl - 4) * 64 + j; if (jj < 0 || jj >= SEQ) return -1;
    return b * POS + CTXL + (jj & 63) * 64 + (jj >> 6);
}
template <int D>
__device__ __forceinline__ void lru_epi_scan(const f32x4 (&acc)[2][4], float brg, float big, float sp, const LAS float* xcf, LAS float* Hs, LAS float* Ps, int ch, int fq, int lane, float& Atot, float& Htot) {
    float hl[4][4], pl[4][4];
    float cA = 1.f, cH = 0.f;
#pragma unroll
    for (int mi = 0; mi < 4; ++mi) {
        const int m = D ? 3 - mi : mi;
        float av[4], bv[4];
#pragma unroll
        for (int rg = 0; rg < 4; ++rg) {
            const int t = 16 * m + 4 * fq + rg;
            const float r = __builtin_amdgcn_rcpf(1.0f + __builtin_amdgcn_exp2f(__builtin_fmaf(acc[0][m][rg], -1.4426950408889634f, brg)));
            const float ig = __builtin_amdgcn_rcpf(1.0f + __builtin_amdgcn_exp2f(__builtin_fmaf(acc[1][m][rg], -1.4426950408889634f, big)));
            av[rg] = __builtin_amdgcn_exp2f(r * sp);
            const float om = __builtin_fmaf(-av[rg], av[rg], 1.0f);
            bv[rg] = __builtin_amdgcn_sqrtf(om) * ig * xcf[t * 64 + ch];
        }
        float H = 0.f, P = 1.f;
#pragma unroll
        for (int qi = 0; qi < 4; ++qi) { const int rg = D ? 3 - qi : qi; H = av[rg] * H + bv[rg]; P *= av[rg]; hl[m][rg] = H; pl[m][rg] = P; }
        float A = P, Hh = H;
        { const float A1 = __shfl(A, D ? lane + 16 : lane - 16), H1 = __shfl(Hh, D ? lane + 16 : lane - 16); const bool ok = D ? (fq <= 2) : (fq >= 1); if (ok) { Hh = A * H1 + Hh; A = A1 * A; } }
        { const float A2 = __shfl(A, D ? lane + 32 : lane - 32), H2 = __shfl(Hh, D ? lane + 32 : lane - 32); const bool ok = D ? (fq <= 1) : (fq >= 2); if (ok) { Hh = A * H2 + Hh; A = A2 * A; } }
        float Ae = __shfl(A, D ? lane + 16 : lane - 16), He = __shfl(Hh, D ? lane + 16 : lane - 16);
        if (D ? (fq == 3) : (fq == 0)) { Ae = 1.f; He = 0.f; }
        const float At = __shfl(A, (lane & 15) + (D ? 0 : 48)), Ht = __shfl(Hh, (lane & 15) + (D ? 0 : 48));
        const float Pin = cA * Ae, Hin = Ae * cH + He;
#pragma unroll
        for (int rg = 0; rg < 4; ++rg) { hl[m][rg] += pl[m][rg] * Hin; pl[m][rg] *= Pin; }
        cH = At * cH + Ht; cA *= At;
    }
    Atot = cA; Htot = cH;
#pragma unroll
    for (int m = 0; m < 4; ++m)
#pragma unroll
        for (int rg = 0; rg < 4; ++rg) { const int t = 16 * m + 4 * fq + rg; Hs[t * 68 + ch] = hl[m][rg]; Ps[t * 68 + ch] = pl[m][rg]; }
}
__device__ __forceinline__ void lru_prefetch(const bf16_t* xg, int U, int tid, u32x4& p0, u32x4& p1, u32x4& pg) {
    const int head = U & 7, bc = U >> 3, b = bc / LCH, cl = bc % LCH;
    const int c8 = (tid & 7) * 8;
    { const int tok = lru_tok(b, cl, (tid >> 3) - 2); p0 = (u32x4){0u, 0u, 0u, 0u}; if (tok >= 0) p0 = *(const u32x4*)(xg + (size_t)tok * 1024 + head * 64 + c8); }
    p1 = (u32x4){0u, 0u, 0u, 0u};
    if (tid < 24) { const int tok = lru_tok(b, cl, 64 + (tid >> 3) - 2); if (tok >= 0) p1 = *(const u32x4*)(xg + (size_t)tok * 1024 + head * 64 + c8); }
    { const int tok = lru_tok(b, cl, tid >> 3); pg = *(const u32x4*)(xg + (size_t)tok * 1024 + 512 + head * 64 + c8); }
}
__device__ __forceinline__ void phase_lru(KArgP a, unsigned char* ws, LAS unsigned char* lds, int layer) {
    const int tid = fresh_tid(), lane = tid & 63, wv = tid >> 6, bid = fresh_bid();
    LAS float* xr_s = (LAS float*)lds;
    LAS float* xcf = (LAS float*)(lds + 17408);
    LAS bf16_t* xcb = (LAS bf16_t*)(lds + 33792);
    LAS float* Hs = (LAS float*)(lds + 43008);
    LAS float* Ps = (LAS float*)(lds + 77824);
    const bf16_t* xg = (const bf16_t*)(ws + WS_XG);
    const int total = NB * LCH * NH;
    const int t_ = tid >> 3, c8 = (tid & 7) * 8;
    const int d = wv >> 2, cbk = wv & 3, fr = lane & 15, fq = lane >> 4, ch = cbk * 16 + fr;
    int cur_head = -1;
    float cw[4][8], cbias[8], brg = 0.f, big = 0.f, sp = 0.f;
    bf16x8 Bf[2][2];
    u32x4 p0, p1, pg;
    int U, ustep, uend;
    if (gridDim.x == 256) { if (bid < 160) { U = bid; ustep = 160; uend = 2560; } else { U = 2560 + (bid - 160); ustep = 96; uend = total; } }
    else { U = (int)gridDim.x - 1 - bid; ustep = (int)gridDim.x; uend = total; }
    if (U < uend) lru_prefetch(xg, U, tid, p0, p1, pg);
    while (U < uend) {
        const int head = U & 7, bc = U >> 3, b = bc / LCH, cl = bc % LCH;
        if (head != cur_head) {
            cur_head = head;
#pragma unroll
            for (int k = 0; k < 4; ++k) { const float* p = a->in[18] + ((size_t)layer * 4 + k) * 512 + head * 64 + c8; const f32x4 u0 = *(const f32x4*)p, u1 = *(const f32x4*)(p + 4);
                cw[k][0] = u0[0]; cw[k][1] = u0[1]; cw[k][2] = u0[2]; cw[k][3] = u0[3]; cw[k][4] = u1[0]; cw[k][5] = u1[1]; cw[k][6] = u1[2]; cw[k][7] = u1[3]; }
            { const float* p = a->in[19] + layer * 512 + head * 64 + c8; const f32x4 u0 = *(const f32x4*)p, u1 = *(const f32x4*)(p + 4);
                cbias[0] = u0[0]; cbias[1] = u0[1]; cbias[2] = u0[2]; cbias[3] = u0[3]; cbias[4] = u1[0]; cbias[5] = u1[1]; cbias[6] = u1[2]; cbias[7] = u1[3]; }
            const bf16_t* Wl = (const bf16_t*)(ws + WS_WL + (size_t)(layer & 1) * WL_SIZE + WL_LRU) + (size_t)head * 256 * 64;
#pragma unroll
            for (int gt = 0; gt < 2; ++gt)
#pragma unroll
                for (int ks = 0; ks < 2; ++ks) Bf[gt][ks] = *(const bf16x8*)(Wl + (size_t)((d * 2 + gt) * 64 + ch) * 64 + ks * 32 + fq * 8);
            const int pidx = (layer * 2 + d) * 512 + head * 64 + ch;
            brg = -1.4426950408889634f * a->in[21][pidx]; big = -1.4426950408889634f * a->in[23][pidx];
            const float ex = __expf(-a->in[24][pidx]);
            sp = ex < 0.1f ? ex * (1.f - ex * (0.5f - ex * (0.33333333f - ex * 0.25f))) : __logf(1.f + ex);
            sp *= -8.0f * 1.4426950408889634f;
        }
        { LAS float* dp = xr_s + t_ * 64 + c8;
          *(LAS f32x4*)dp = (f32x4){bf_lo(p0.x), bf_hi(p0.x), bf_lo(p0.y), bf_hi(p0.y)}; *(LAS f32x4*)(dp + 4) = (f32x4){bf_lo(p0.z), bf_hi(p0.z), bf_lo(p0.w), bf_hi(p0.w)};
          if (tid < 24) { LAS float* dq = xr_s + (64 + t_) * 64 + c8;
            *(LAS f32x4*)dq = (f32x4){bf_lo(p1.x), bf_hi(p1.x), bf_lo(p1.y), bf_hi(p1.y)}; *(LAS f32x4*)(dq + 4) = (f32x4){bf_lo(p1.z), bf_hi(p1.z), bf_lo(p1.w), bf_hi(p1.w)}; } }
        const u32x4 gv = pg;
        __syncthreads();
        const int Un = U + ustep;
        if (Un < uend) lru_prefetch(xg, Un, tid, p0, p1, pg);
        {
            float v[8];
#pragma unroll
            for (int e = 0; e < 8; ++e) v[e] = cbias[e];
#pragma unroll
            for (int k = 0; k < 4; ++k) { const f32x4 x0 = *(const LAS f32x4*)(xr_s + (t_ + k) * 64 + c8), x1 = *(const LAS f32x4*)(xr_s + (t_ + k) * 64 + c8 + 4);
#pragma unroll
                for (int e = 0; e < 4; ++e) { v[e] += cw[k][e] * x0[e]; v[4 + e] += cw[k][4 + e] * x1[e]; } }
            *(LAS f32x4*)(xcf + t_ * 64 + c8) = (f32x4){v[0], v[1], v[2], v[3]}; *(LAS f32x4*)(xcf + t_ * 64 + c8 + 4) = (f32x4){v[4], v[5], v[6], v[7]};
            u32x4 w; w.x = cvt_pk_bf16(v[0], v[1]); w.y = cvt_pk_bf16(v[2], v[3]); w.z = cvt_pk_bf16(v[4], v[5]); w.w = cvt_pk_bf16(v[6], v[7]);
            *(LAS u32x4*)(xcb + t_ * 72 + c8) = w;
        }
        __syncthreads();
        {
            bf16x8 Af[4][2];
#pragma unroll
            for (int m = 0; m < 4; ++m)
#pragma unroll
                for (int ks = 0; ks < 2; ++ks) Af[m][ks] = *(const LAS bf16x8*)(xcb + (16 * m + fr) * 72 + ks * 32 + fq * 8);
            f32x4 acc[2][4];
#pragma unroll
            for (int gt = 0; gt < 2; ++gt)
#pragma unroll
                for (int m = 0; m < 4; ++m) { acc[gt][m] = (f32x4){0.f, 0.f, 0.f, 0.f};
#pragma unroll
                    for (int ks = 0; ks < 2; ++ks) acc[gt][m] = __builtin_amdgcn_mfma_f32_16x16x32_bf16(Af[m][ks], Bf[gt][ks], acc[gt][m], 0, 0, 0); }
            float At, Ht;
            if (d == 0) lru_epi_scan<0>(acc, brg, big, sp, xcf, Hs, Ps, ch, fq, lane, At, Ht);
            else lru_epi_scan<1>(acc, brg, big, sp, xcf, Hs + 64 * 68, Ps + 64 * 68, ch, fq, lane, At, Ht);
            if (fq == 0) ((f32x2*)(ws + WS_LAGG))[((size_t)(b * LCH + cl) * 2 + d) * 512 + head * 64 + ch] = mk2(At, Ht);
        }
        __syncthreads();
        {
            const int tok = lru_tok(b, cl, t_);
            const float gr[8] = {bf_lo(gv.x), bf_hi(gv.x), bf_lo(gv.y), bf_hi(gv.y), bf_lo(gv.z), bf_hi(gv.z), bf_lo(gv.w), bf_hi(gv.w)};
            float yl[8], gf[8], gb[8];
            { const int o = t_ * 68 + c8;
              const f32x4 h00 = *(const LAS f32x4*)(Hs + o), h01 = *(const LAS f32x4*)(Hs + o + 4), h10 = *(const LAS f32x4*)(Hs + 64 * 68 + o), h11 = *(const LAS f32x4*)(Hs + 64 * 68 + o + 4);
              const f32x4 q00 = *(const LAS f32x4*)(Ps + o), q01 = *(const LAS f32x4*)(Ps + o + 4), q10 = *(const LAS f32x4*)(Ps + 64 * 68 + o), q11 = *(const LAS f32x4*)(Ps + 64 * 68 + o + 4);
#pragma unroll
              for (int e = 0; e < 4; ++e) { const float g0 = gelu_tanh(gr[e]), g1 = gelu_tanh(gr[4 + e]);
                yl[e] = (h00[e] + h10[e]) * g0; gf[e] = q00[e] * g0; gb[e] = q10[e] * g0;
                yl[4 + e] = (h01[e] + h11[e]) * g1; gf[4 + e] = q01[e] * g1; gb[4 + e] = q11[e] * g1; } }
            const size_t off = (size_t)tok * 512 + head * 64 + c8;
            u32x4 w; w.x = cvt_pk_bf16(yl[0], yl[1]); w.y = cvt_pk_bf16(yl[2], yl[3]); w.z = cvt_pk_bf16(yl[4], yl[5]); w.w = cvt_pk_bf16(yl[6], yl[7]);
            *(u32x4*)((bf16_t*)(ws + WS_YL) + off) = w;
            w.x = cvt_pk_bf16(gf[0], gf[1]); w.y = cvt_pk_bf16(gf[2], gf[3]); w.z = cvt_pk_bf16(gf[4], gf[5]); w.w = cvt_pk_bf16(gf[6], gf[7]);
            *(u32x4*)((bf16_t*)(ws + WS_GPF) + off) = w;
            w.x = cvt_pk_bf16(gb[0], gb[1]); w.y = cvt_pk_bf16(gb[2], gb[3]); w.z = cvt_pk_bf16(gb[4], gb[5]); w.w = cvt_pk_bf16(gb[6], gb[7]);
            *(u32x4*)((bf16_t*)(ws + WS_R2) + (size_t)tok * 1024 + head * 64 + c8) = w;
        }
        U = Un;
    }
    __syncthreads();
}
__device__ __forceinline__ void phase_lru_fin(unsigned char* ws) {
    const int tid = fresh_tid(), bid0 = fresh_bid();
    const float* lh = (const float*)(ws + WS_LHIN);
    const int nskip = gridDim.x >= 128 ? 64 : 0;
    if (bid0 < nskip) return;
    const int bid = bid0 - nskip, nb = (int)gridDim.x - nskip;
    for (int item = bid * 512 + tid; item < MTOK * 64; item += nb * 512) {
        const int tok = item >> 6, c8 = (item & 63) * 8, b = tok / POS, pos = tok % POS;
        const int cl = pos < CTXL ? (pos >> 6) : 4 + ((pos - CTXL) & 63);
        const size_t off = (size_t)tok * 512 + c8;
        const u32x4 yv = *(const u32x4*)((const bf16_t*)(ws + WS_YL) + off), fv = *(const u32x4*)((const bf16_t*)(ws + WS_GPF) + off), rv = *(const u32x4*)((const bf16_t*)(ws + WS_R2) + (size_t)tok * 1024 + c8);
        const float* hf = lh + ((size_t)(b * LCH + cl) * 2) * 512 + c8; const float* hr = hf + 512;
        const f32x4 f0 = *(const f32x4*)hf, f1 = *(const f32x4*)(hf + 4), r0 = *(const f32x4*)hr, r1 = *(const f32x4*)(hr + 4);
        u32x4 w;
        w.x = cvt_pk_bf16(bf_lo(yv.x) + bf_lo(fv.x) * f0[0] + bf_lo(rv.x) * r0[0], bf_hi(yv.x) + bf_hi(fv.x) * f0[1] + bf_hi(rv.x) * r0[1]);
        w.y = cvt_pk_bf16(bf_lo(yv.y) + bf_lo(fv.y) * f0[2] + bf_lo(rv.y) * r0[2], bf_hi(yv.y) + bf_hi(fv.y) * f0[3] + bf_hi(rv.y) * r0[3]);
        w.z = cvt_pk_bf16(bf_lo(yv.z) + bf_lo(fv.z) * f1[0] + bf_lo(rv.z) * r1[0], bf_hi(yv.z) + bf_hi(fv.z) * f1[1] + bf_hi(rv.z) * r1[1]);
        w.w = cvt_pk_bf16(bf_lo(yv.w) + bf_lo(fv.w) * f1[2] + bf_lo(rv.w) * r1[2], bf_hi(yv.w) + bf_hi(fv.w) * f1[3] + bf_hi(rv.w) * r1[3]);
        *(u32x4*)((bf16_t*)(ws + WS_R2) + (size_t)tok * 1024 + 512 + c8) = w;
    }
}

__device__ __forceinline__ void phase_carry(unsigned char* ws) {
    const int tid = fresh_tid(), bid = fresh_bid();
    const int lane = tid & 63, wid = tid >> 6;
    for (int item = wid * gridDim.x + bid; item < 640; item += 8 * gridDim.x) {
        if (item < 512) {
            const int g = item >> 4, b = (item >> 1) & 7, d = item & 1, n = lane;
            const f32x2 aT = ((const f32x2*)(ws + WS_AT))[(g * 2 + d) * 64 + n];
            const f32x2* hl = (const f32x2*)(ws + WS_HLOC) + ((size_t)(g * MS + b * SCH) * 256 + d * 128 + 2 * n) / 2;
            unsigned* hin = (unsigned*)(ws + WS_US5) + ((size_t)(g * MSP + b * SCH) * K3 + 512 + d * 128 + 2 * n) / 2;
            float hr = 0.f, hi = 0.f;
            for (int ib = 0; ib < SCH / 8; ++ib) {
                f32x2 L[8];
#pragma unroll
                for (int e = 0; e < 8; ++e) { const int i = ib * 8 + e, c = d == 0 ? i : (i < 8 ? 7 - i : 143 - i); L[e] = hl[(size_t)c * 128]; }
#pragma unroll
                for (int e = 0; e < 8; ++e) { const int i = ib * 8 + e, c = d == 0 ? i : (i < 8 ? 7 - i : 143 - i);
                    hin[(size_t)c * (K3 / 2)] = cvt_pk_bf16(hr, hi);
                    const float nr = aT.x * hr - aT.y * hi + L[e].x, ni = aT.x * hi + aT.y * hr + L[e].y; hr = nr; hi = ni; }
            }
        } else {
            const int tl = (item - 512) * 64 + lane, b = tl >> 10, d = (tl >> 9) & 1, ch = tl & 511;
            const f32x2* ag = (const f32x2*)(ws + WS_LAGG) + ((size_t)b * LCH * 2 + d) * 512 + ch;
            float* hin = (float*)(ws + WS_LHIN) + ((size_t)b * LCH * 2 + d) * 512 + ch;
            float H = 0.f;
            for (int ib = 0; ib < LCH / 4; ++ib) {
                f32x2 L[4];
#pragma unroll
                for (int e = 0; e < 4; ++e) { const int i = ib * 4 + e, cl = d == 0 ? i : (i < 4 ? 3 - i : 71 - i); L[e] = ag[(size_t)cl * 1024]; }
#pragma unroll
                for (int e = 0; e < 4; ++e) { const int i = ib * 4 + e, cl = d == 0 ? i : (i < 4 ? 3 - i : 71 - i); hin[(size_t)cl * 1024] = H; H = L[e].x * H + L[e].y; }
            }
        }
    }
}

#define XB_TMO      128
#define XB_XCNT(j)  (256  + 64 * (j))
#define XB_XSUB(j)  (1280 + 64 * (j))
#define XB_XGEN(j)  (2304 + 64 * (j))
#define XB_TOP      3328
#define XB_TOPGEN   3392
#define XCD_BAR_WORDS 3456
#define XB_SPIN_CAP (1u << 22)
__device__ __forceinline__ unsigned xb_ld(unsigned* p)              { return __hip_atomic_load(p, __ATOMIC_RELAXED, __HIP_MEMORY_SCOPE_AGENT); }
__device__ __forceinline__ unsigned xb_add(unsigned* p, unsigned v) { return __hip_atomic_fetch_add(p, v, __ATOMIC_RELAXED, __HIP_MEMORY_SCOPE_AGENT); }
__device__ __forceinline__ unsigned xb_xcc_id() { return (unsigned)__builtin_amdgcn_s_getreg((3 << 11) | 20) & 0xFu; }
#define XB_SPIN(cond, bar) do { unsigned _sp = 0; while (cond) { __builtin_amdgcn_s_sleep(1); \
    if ((++_sp & 255u) == 0u) { if (xb_ld(&(bar)[XB_TMO])) break; if (_sp > XB_SPIN_CAP) { atomicAdd(&(bar)[XB_TMO], 1u); break; } } } } while (0)
__device__ __forceinline__ void xcd_barrier_complete(unsigned* bar, unsigned x, unsigned& nloc, unsigned& nx) {
    const unsigned G = gridDim.x * gridDim.y * gridDim.z;
    unsigned sum, cnt, mine, sp = 0u;
    for (;;) {
        sum = 0u; cnt = 0u; mine = 0u;
#pragma unroll
        for (unsigned j = 0; j < 16; ++j) { const unsigned c = xb_ld(&bar[XB_XCNT(j)]); sum += c; cnt += (c > 0u) ? 1u : 0u; mine = (j == x) ? c : mine; }
        if (sum == G) break;
        __builtin_amdgcn_s_sleep(1);
        if ((++sp & 255u) == 0u) { if (xb_ld(&bar[XB_TMO])) break; if (sp > XB_SPIN_CAP) { atomicAdd(&bar[XB_TMO], 1u); break; } }
    }
    nloc = mine > 0u ? mine : 1u; nx = cnt > 0u ? cnt : 1u;
}
__device__ __forceinline__ void xcd_barrier(unsigned* bar, volatile LAS unsigned* st) {
    asm volatile("s_waitcnt vmcnt(0)" ::: "memory");
    __syncthreads();
    if (threadIdx.x == 0) {
        const unsigned x = xb_xcc_id();
        __builtin_amdgcn_s_waitcnt(0);
        unsigned nloc = st[0], nx = st[1];
        if (nloc == 0u) { xcd_barrier_complete(bar, x, nloc, nx); st[0] = nloc; st[1] = nx; }
        const unsigned old = xb_add(&bar[XB_XSUB(x)], 1u);
        const unsigned gen = old / nloc;
        if (old + 1u == (gen + 1u) * nloc) {
            __builtin_amdgcn_fence(__ATOMIC_RELEASE, "agent");
            asm volatile("s_waitcnt vmcnt(0)" ::: "memory");
            const unsigned og = xb_add(&bar[XB_TOP], 1u);
            const unsigned tg = og / nx;
            if (og + 1u == (tg + 1u) * nx) xb_add(&bar[XB_TOPGEN], 1u);
            else XB_SPIN(xb_ld(&bar[XB_TOPGEN]) == tg, bar);
            __builtin_amdgcn_fence(__ATOMIC_ACQUIRE, "agent");
            xb_add(&bar[XB_XGEN(x)], 1u);
            asm volatile("s_waitcnt vmcnt(0)" ::: "memory");
        } else {
            XB_SPIN(xb_ld(&bar[XB_XGEN(x)]) == gen, bar);
            __builtin_amdgcn_fence(__ATOMIC_ACQUIRE, "agent");
            asm volatile("s_waitcnt vmcnt(0)" ::: "memory");
        }
    }
    __syncthreads();
}

__global__ void __launch_bounds__(512, 2) mega(Args a_unused) {
    extern __shared__ __attribute__((aligned(16))) unsigned char lds_raw[];
    LAS unsigned char* lds = (LAS unsigned char*)lds_raw;
    cg::grid_group grid = cg::this_grid();
    const int G = gridDim.x, c = blockIdx.x;
    volatile LAS unsigned* bst = (volatile LAS unsigned*)(lds + (LDS_BYTES - 16));
    unsigned* const gbar = (unsigned*)(kargs()->ws + WS_BAR);
    if (threadIdx.x == 0) { bst[0] = 0u; bst[1] = 0u; (void)xb_add(&gbar[XB_XCNT(xb_xcc_id())], 1u); }
    __syncthreads();
#define GSYNC() do { xcd_barrier(gbar, bst); if (PROBE_ID == 15) { xcd_barrier(gbar, bst); xcd_barrier(gbar, bst); } } while (0)
#define PH_BEGIN KArgP a = kargs(); unsigned char* ws = fresh_ws(); (void)a; (void)ws;

    if (G >= 64) {
        if (c < 32) { PH_BEGIN s5tab_group(a, ws, lds, 0, c); }
        else { { PH_BEGIN phase_mod(a, ws, lds, c - 32, G - 32); } { PH_BEGIN phase_wconv(a, ws, lds, 0, c - 32, G - 32); } }
    } else {
        { PH_BEGIN for (int g = c; g < NG; g += G) s5tab_group(a, ws, lds, 0, g); }
        { PH_BEGIN phase_mod(a, ws, lds, c, G); }
        { PH_BEGIN phase_wconv(a, ws, lds, 0, c, G); }
    }
    grid.sync();
#if PM & 8
    { PH_BEGIN PB(2) phase_norm<0>(a, ws, 0); PE(2) }
#endif
    GSYNC();

#pragma unroll 1
    for (int l = 0; l < DEPTH; ++l) {
#if PM & 16
        for (int rep = 0; rep < REP_GEMM; ++rep) { PH_BEGIN PB(5) unsigned char* wl = ws + WS_WL + (size_t)(l & 1) * WL_SIZE;
          PlainOrder S; S.init(ws + WS_R2, 1024, wl + WL_IN, 1024, MTOK, DIN, G, c); EpiIn E{(bf16_t*)(ws + WS_US5), (bf16_t*)(ws + WS_XG)};
          gemm_phase<EpiIn, PlainOrder>(lds, 1024, 1024, 1024, S, E); PE(5) }
#endif
        GSYNC();
#if PM & 32
        for (int rep = 0; rep < REP_GEMM; ++rep) { PH_BEGIN PB(6) BatchOrder S; S.init(ws + WS_US5, K3, (size_t)MSP * K3 * 2, ws + WS_BT1, K1, (size_t)256 * K1 * 2, MSP / BM, 1, NG, G, c); EpiHloc E{(float*)(ws + WS_HLOC)};
          gemm_phase<EpiHloc, BatchOrder>(lds, K3, K1, K1, S, E); PE(6) }
#endif
#if PM & 2048
        for (int rep = 0; rep < REP_LRU; ++rep) { PH_BEGIN PB(3) phase_lru(a, ws, lds, l); PE(3) }
#endif
        GSYNC();
#if PM & 8192
        for (int rep = 0; rep < REP_CARRY; ++rep) { PH_BEGIN PB(13) phase_carry(ws); PE(13) }
#endif
        GSYNC();
#if PM & 64
        for (int rep = 0; rep < REP_GEMM; ++rep) { PH_BEGIN PB(7) BatchOrder S; S.init(ws + WS_US5, K3, (size_t)MSP * K3 * 2, ws + WS_BT3, K3, (size_t)512 * K3 * 2, MSP / BM, 2, NG, G, c); EpiY1 E{(bf16_t*)(ws + WS_Y1)};
          gemm_phase<EpiY1, BatchOrder>(lds, K3, K3, K3, S, E); PE(7) }
#endif
#if PM & 4096
        for (int rep = 0; rep < REP_LRU; ++rep) { PH_BEGIN PB(4) phase_lru_fin(ws); PE(4) }
#endif
        GSYNC();
#if PM & 128
        for (int rep = 0; rep < REP_GEMM; ++rep) { PH_BEGIN PB(8) unsigned char* wl = ws + WS_WL + (size_t)(l & 1) * WL_SIZE;
          PlainOrder S; S.init(ws + WS_Y1, 512, wl + WL_GLU, 512, MTOK, 512, G, c, l == DEPTH - 1); EpiGlu E{(const bf16_t*)(ws + WS_Y1), (bf16_t*)(ws + WS_R2), a->in[17] + l * 512};
          gemm_phase<EpiGlu, PlainOrder>(lds, 512, 512, 512, S, E); PE(8) }
#endif
        GSYNC();
        { PH_BEGIN PB(9) unsigned char* wl = ws + WS_WL + (size_t)(l & 1) * WL_SIZE; unsigned* ctr = (unsigned*)(ws + WS_CTR) + (l * 2 + 0) * 256;
          PanelOrder S; S.init(ws + WS_R2, 1024, wl + WL_OUT, 1024, G, c, l == DEPTH - 1); EpiOutPub E{(bf16_t*)(ws + WS_R3), (float*)(ws + WS_ROWSS), ctr};
          gemm_phase<EpiOutPub, PanelOrder>(lds, 1024, 1024, 1024, S, E); PE(9) }
        { PH_BEGIN PB(2) unsigned* ctr = (unsigned*)(ws + WS_CTR) + (l * 2 + 0) * 256; norm_tasks<1>(a, ws, lds, l, ctr, l == DEPTH - 1); PE(2) }
        GSYNC();
#if PM & 512
        for (int rep = 0; rep < REP_GEMM; ++rep) { PH_BEGIN PB(10) unsigned char* wl = ws + WS_WL + (size_t)(l & 1) * WL_SIZE;
          PlainOrder S; S.init(ws + WS_R2, 1024, wl + WL_FI, 1024, MTOK, 2 * DFF, G, c, l == DEPTH - 1); EpiFfn E{(bf16_t*)(ws + WS_AFF)};
          gemm_phase<EpiFfn, PlainOrder>(lds, 1024, 1024, 1024, S, E); PE(10) }
#endif
        GSYNC();
        { PH_BEGIN PB(11) unsigned char* wl = ws + WS_WL + (size_t)(l & 1) * WL_SIZE; unsigned* ctr = (unsigned*)(ws + WS_CTR) + (l * 2 + 1) * 256;
          PanelOrder S; S.init(ws + WS_AFF, DFF, wl + WL_FO, DFF, G, c, l == DEPTH - 1); EpiOutPub E{(bf16_t*)(ws + WS_R3), (float*)(ws + WS_ROWSS), ctr};
          gemm_phase<EpiOutPub, PanelOrder>(lds, DFF, DFF, DFF, S, E); PE(11) }
        if (l + 1 < DEPTH) { PH_BEGIN PB(14)
            if (G >= 128) { if (c >= 32 && c < 64) s5tab_group(a, ws, lds, l + 1, c - 32); else if (c >= 64) phase_wconv(a, ws, lds, l + 1, c - 64, G - 64); }
            else { for (int g = c; g < NG; g += G) s5tab_group(a, ws, lds, l + 1, g); phase_wconv(a, ws, lds, l + 1, c, G); }
            PE(14) }
        { PH_BEGIN PB(2) unsigned* ctr = (unsigned*)(ws + WS_CTR) + (l * 2 + 1) * 256; norm_tasks<2>(a, ws, lds, l, ctr, l == DEPTH - 1); PE(2) }
        if (l + 1 < DEPTH) GSYNC();
    }
}

extern "C" void kernel_launch(void* const* d_in, const int* in_sizes, int n_in, void* d_out, int out_size, void* d_ws, size_t ws_size, hipStream_t stream) {
    static int grid = 0;
    if (grid == 0) {
        if (n_in != 28 || out_size != NB * SEQ * D || ws_size < WS_END) { fprintf(stderr, "kernel_launch: unexpected shapes (n_in %d, out %d, ws %zu, need %zu)\n", n_in, out_size, ws_size, (size_t)WS_END); grid = -1; return; }
        int dev = 0, cus = 0, per_cu = 0;
        hipGetDevice(&dev); hipDeviceGetAttribute(&cus, hipDeviceAttributeMultiprocessorCount, dev);
        if (hipFuncSetAttribute((const void*)mega, hipFuncAttributeMaxDynamicSharedMemorySize, LDS_BYTES) != hipSuccess) { fprintf(stderr, "kernel_launch: hipFuncSetAttribute failed\n"); grid = -1; return; }
        if (hipOccupancyMaxActiveBlocksPerMultiprocessor(&per_cu, (const void*)mega, 512, LDS_BYTES) != hipSuccess || per_cu < 1) { fprintf(stderr, "kernel_launch: occupancy query says %d\n", per_cu); per_cu = 1; }
        (void)hipGetLastError();
        grid = cus * 1;
        if (grid <= 0) grid = 256;
    }
    if (grid < 0) return;
    if (hipMemsetAsync((char*)d_ws + WS_BAR, 0, 16384 + 8192, stream) != hipSuccess) { fprintf(stderr, "kernel_launch: memset failed\n"); return; }
    Args a{};
    for (int i = 0; i < 28; ++i) a.in[i] = (const float*)d_in[i];
    a.out = (float*)d_out; a.ws = (unsigned char*)d_ws;
    void* args[] = {&a};
    hipError_t e = hipLaunchCooperativeKernel((const void*)mega, dim3(grid), dim3(512), args, LDS_BYTES, stream);
    if (e != hipSuccess) fprintf(stderr, "kernel_launch: cooperative launch failed: %s (grid %d)\n", hipGetErrorString(e), grid);
}
```

```cpp
#include <hip/hip_runtime.h>
#include <hip/hip_cooperative_groups.h>
#include <cstdio>
namespace cg = cooperative_groups;

#define LAS __attribute__((address_space(3)))
#ifndef PM
#define PM 65535
#endif
#ifndef REP_LRU
#define REP_LRU 1
#endif
#ifndef REP_P0
#define REP_P0 1
#endif
#ifndef REP_CARRY
#define REP_CARRY 1
#endif
#ifndef PROBE_ID
#define PROBE_ID 0
#endif
#define PB(id) const unsigned long long _t0 = (PROBE_ID == (id)) ? __builtin_amdgcn_s_memrealtime() : 0ull;
#define PE(id) if (PROBE_ID == (id)) { const unsigned long long _dt = __builtin_amdgcn_s_memrealtime() - _t0, _t1 = __builtin_amdgcn_s_memrealtime(); while (__builtin_amdgcn_s_memrealtime() - _t1 < 4ull * _dt) __builtin_amdgcn_s_sleep(8); }
#ifndef REP_GEMM
#define REP_GEMM 1
#endif
typedef unsigned short bf16_t;
typedef short bf16x8 __attribute__((ext_vector_type(8)));
typedef float f32x4 __attribute__((ext_vector_type(4)));
typedef unsigned u32x4 __attribute__((ext_vector_type(4)));
typedef float f32x2 __attribute__((ext_vector_type(2)));

constexpr int D = 1024, NB = 8, SEQ = 4096, DEPTH = 4, CTXL = 256, POS = CTXL + SEQ, MTOK = NB * POS;
constexpr int DS5 = 512, NG = 32, DLRU = 512, NH = 8, DIN = 1536, DFF = 2816;
constexpr int TS = 32, SCH = POS / TS, MS = NB * SCH, MSP = 1280, K3 = 768, K1 = 512;
constexpr int LCH = 68;
constexpr float EPS = 1e-6f;
constexpr int LDS_BYTES = 147456;

constexpr size_t WS_MOD = 0;
constexpr size_t WS_WL = WS_MOD + 4 * 9 * 6144 * 4;
constexpr size_t WL_IN = 0, WL_GLU = WL_IN + 3145728, WL_OUT = WL_GLU + 524288, WL_FI = WL_OUT + 2097152, WL_FO = WL_FI + 11534336, WL_LRU = WL_FO + 5767168, WL_SIZE = WL_LRU + 262144;
constexpr size_t WS_BT3 = WS_WL + 2 * WL_SIZE;
constexpr size_t WS_BT1 = WS_BT3 + 25165824;
constexpr size_t WS_AT = WS_BT1 + 8388608;
constexpr size_t WS_BIG = WS_AT + 32768;
constexpr size_t WS_US5 = WS_BIG;
constexpr size_t WS_XG = WS_US5 + 62914560;
constexpr size_t WS_HLOC = WS_XG + 71303168;
constexpr size_t WS_Y1 = WS_HLOC + 35651584;
constexpr size_t BIG_SIZE = 205520896;
constexpr size_t WS_AFF = WS_BIG;
constexpr size_t WS_R2 = WS_BIG + BIG_SIZE;
constexpr size_t WS_R3 = WS_R2 + 71303168;
constexpr size_t WS_ROWSS = WS_R3 + 71303168;
constexpr size_t WS_LAGG = WS_ROWSS + 2228224;
constexpr size_t WS_LHIN = WS_LAGG + 4456448;
constexpr size_t WS_YL = WS_R3, WS_GPF = WS_R3 + 35651584;
constexpr size_t WS_BAR = WS_LHIN + 2228224;
constexpr size_t WS_CTR = WS_BAR + 16384;
constexpr size_t WS_XB = WS_CTR + 8192;
constexpr size_t WS_END = WS_XB + 71303168;

struct Args { const float* in[28]; float* out; unsigned char* ws; };
typedef const Args __attribute__((address_space(4)))* KArgP;
__device__ __forceinline__ KArgP kargs() { KArgP p = (KArgP)__builtin_amdgcn_kernarg_segment_ptr(); asm volatile("" : "+s"(p)); return p; }
__device__ __forceinline__ int fresh_tid() { int t = threadIdx.x; asm volatile("" : "+v"(t)); return t; }
__device__ __forceinline__ int fresh_bid() { int t = blockIdx.x; asm volatile("" : "+s"(t)); return t; }
__device__ __forceinline__ unsigned char* fresh_ws() { unsigned char* w = kargs()->ws; asm volatile("" : "+s"(w)); return w; }

__device__ __forceinline__ f32x2 mk2(float x, float y) { f32x2 r; r.x = x; r.y = y; return r; }
__device__ __forceinline__ unsigned cvt_pk_bf16(float lo, float hi) { unsigned r; asm("v_cvt_pk_bf16_f32 %0, %1, %2" : "=v"(r) : "v"(lo), "v"(hi)); return r; }
__device__ __forceinline__ void st16_wt(void* p, u32x4 v) { asm volatile("global_store_dwordx4 %0, %1, off sc1\n\ts_nop 1" :: "v"(p), "v"(v) : "memory"); }
__device__ __forceinline__ void st4_wt(void* p, float v) { asm volatile("global_store_dword %0, %1, off sc1\n\ts_nop 1" :: "v"(p), "v"(v) : "memory"); }
typedef _Float16 h2_t __attribute__((ext_vector_type(2)));
__device__ __forceinline__ unsigned pk_h2(float lo, float hi) { h2_t v; v.x = (_Float16)lo; v.y = (_Float16)hi; return __builtin_bit_cast(unsigned, v); }
__device__ __forceinline__ float h_lo(unsigned w) { const h2_t v = __builtin_bit_cast(h2_t, w); return (float)v.x; }
__device__ __forceinline__ float h_hi(unsigned w) { const h2_t v = __builtin_bit_cast(h2_t, w); return (float)v.y; }
__device__ __forceinline__ float bf_lo(unsigned w) { return __uint_as_float(w << 16); }
__device__ __forceinline__ float bf_hi(unsigned w) { return __uint_as_float(w & 0xffff0000u); }
__device__ __forceinline__ float sigmoidf_(float x) { return __frcp_rn(1.0f + __expf(-x)); }
__device__ __forceinline__ float gelu_tanh(float x) { const float u = 1.5957691216057308f * (x + 0.044715f * x * x * x); return x * __frcp_rn(1.0f + __expf(-u)); }
__device__ __forceinline__ float siluf_(float x) { return x * __frcp_rn(1.0f + __expf(-x)); }

constexpr int BM = 256, BK = 64, HALF = 128, HTB = HALF * BK * 2, NXCD = 8, WGM = 8;
__device__ __forceinline__ int lds_byte(int r, int c) { const int st = (r >> 4) * 2 + (c >> 5), rr = r & 15, cc = c & 31, ob = rr * 64 + cc * 2; return st * 1024 + (ob ^ (((ob >> 9) & 1) << 5)); }
__device__ __forceinline__ void stage_rc(int b, int& R, int& C) { const int st = b / 1024, sb = b % 1024, swz = sb ^ (((sb >> 9) & 1) << 5); R = (st >> 1) * 16 + swz / 64; C = (st & 1) * 32 + (swz % 64) / 2; }
__device__ __forceinline__ int perm32(int rho) { const int n = rho >> 4, i = rho & 15; return 8 * (i >> 2) + 4 * n + (i & 3); }

struct Unit { const char* A; const char* B; int pm, pn, g; };

struct PlainOrder {
    const char* A; const char* B; size_t tA, tB; int nM, nN, nwg, G, c;
    __device__ void init(const void* A_, int lda, const void* B_, int ldb, int M, int N, int G_, int c_, int skipctx = 0) {
        A = (const char*)A_; B = (const char*)B_; tA = (size_t)BM * lda * 2; tB = (size_t)BM * ldb * 2; nM = M / BM; nN = N / BM; if (skipctx) nM = NB * 16; nwg = nM * nN; G = G_; c = c_; }
    __device__ __forceinline__ bool next(int i, Unit& u) const {
        const long L = (long)i * G + c; if (L >= nwg) return false;
        int wgid = (int)L; { const int q = nwg / NXCD, r = nwg % NXCD, xcd = wgid % NXCD, off = wgid / NXCD; wgid = (xcd < r ? xcd * (q + 1) : r * (q + 1) + (xcd - r) * q) + off; }
        const int nig = WGM * nN, gid = wgid / nig, fm = gid * WGM, gsz = (nM - fm) < WGM ? (nM - fm) : WGM;
        u.pm = fm + ((wgid % nig) % gsz); u.pn = (wgid % nig) / gsz; u.g = 0;
        if (nM == NB * 16) u.pm = u.pm + (u.pm >> 4) + 1;
        u.A = A + (size_t)u.pm * tA; u.B = B + (size_t)u.pn * tB; return true;
    }
};
struct BatchOrder {
    const char* A; const char* B; size_t tA, tB, gA, gB; int nM, nN, total, G, c;
    __device__ void init(const void* A_, int lda, size_t gA_, const void* B_, int ldb, size_t gB_, int nM_, int nN_, int ng, int G_, int c_) {
        A = (const char*)A_; B = (const char*)B_; tA = (size_t)BM * lda * 2; tB = (size_t)BM * ldb * 2; gA = gA_; gB = gB_; nM = nM_; nN = nN_; total = nM_ * nN_ * ng; G = G_; c = c_; }
    __device__ __forceinline__ bool next(int i, Unit& u) const {
        const long L = (long)i * G + c; if (L >= total) return false;
        const int per = nM * nN, g = (int)L / per, r = (int)L % per; u.g = g; u.pn = r / nM; u.pm = r % nM;
        u.A = A + (size_t)g * gA + (size_t)u.pm * tA; u.B = B + (size_t)g * gB + (size_t)u.pn * tB; return true;
    }
};

template <class Epi, class Sched>
__device__ __forceinline__ void gemm_phase(LAS unsigned char* lds, const int lda, const int ldb, const int K, const Sched& S, const Epi& E) {
    int tid_ = threadIdx.x; asm volatile("" : "+v"(tid_));
    const int tid = tid_, wid = __builtin_amdgcn_readfirstlane(tid >> 6), lane = tid & 63, wr = wid >> 2, wc = wid & 3, fr = lane & 15, fq = lane >> 4;
    const int nt = K / BK;
    unsigned voffA[2], voffB[2];
#pragma unroll
    for (int i = 0; i < 2; ++i) { int R, C; stage_rc(tid * 16 + i * 8192, R, C); const int Rb = Epi::PERM ? ((R & ~31) + perm32(R & 31)) : R;
        voffA[i] = (unsigned)(R * lda + C) * 2u; voffB[i] = (unsigned)(Rb * ldb + C) * 2u; }
    const size_t kstep = (size_t)(BK * 2);
    const size_t hstepA = (size_t)HALF * lda * 2, hstepB = (size_t)HALF * ldb * 2;
    const unsigned ldsw = (unsigned)wid * 1024u;
    const int aoff = lds_byte(wr * 64 + fr, fq * 8), boff = lds_byte(wc * 32 + fr, fq * 8);
#define PG8_SA(b, h) (((b) * 2 + (h)) * HTB)
#define PG8_SB(b, h) ((4 + (b) * 2 + (h)) * HTB)
#define PG8_STAGE(bufoff, gbase, voff) do { _Pragma("unroll") for (int _i = 0; _i < 2; ++_i) \
        __builtin_amdgcn_global_load_lds((const unsigned*)((const char*)(gbase) + (voff)[_i]), (LAS unsigned*)(lds + (bufoff) + ldsw + _i * 8192), 16, 0, 0); } while (0)
#define PG8_LDA(dst, b, h) do { _Pragma("unroll") for (int m = 0; m < 4; ++m) _Pragma("unroll") for (int k = 0; k < 2; ++k) dst[m][k] = *(const LAS bf16x8*)(lds + PG8_SA(b, h) + aoff + m * 2048 + k * 1024); } while (0)
#define PG8_LDB(dst, b, h) do { _Pragma("unroll") for (int n = 0; n < 2; ++n) _Pragma("unroll") for (int k = 0; k < 2; ++k) dst[n][k] = *(const LAS bf16x8*)(lds + PG8_SB(b, h) + boff + n * 2048 + k * 1024); } while (0)
#define PG8_MMA(ai, bj, At, Bt) do { __builtin_amdgcn_s_setprio(1); _Pragma("unroll") for (int m = 0; m < 4; ++m) _Pragma("unroll") for (int n = 0; n < 2; ++n) _Pragma("unroll") for (int k = 0; k < 2; ++k) \
        acc[ai][bj][m][n] = __builtin_amdgcn_mfma_f32_16x16x32_bf16(Bt[n][k], At[m][k], acc[ai][bj][m][n], 0, 0, 0); __builtin_amdgcn_s_setprio(0); } while (0)
#define PG8_WAIT_V(n) asm volatile("s_waitcnt vmcnt(" #n ")" ::: "memory")
#define PG8_WAIT_L(n) asm volatile("s_waitcnt lgkmcnt(" #n ")" ::: "memory")
#define PG8_BAR __builtin_amdgcn_s_barrier()
#define PG8_SCHED __builtin_amdgcn_sched_barrier(0)
    Unit cur, nxt; int ui = 0;
    if (!S.next(0, cur)) return;
    f32x4 acc[2][2][4][2];
#pragma unroll
    for (int a = 0; a < 2; ++a)
#pragma unroll
        for (int b = 0; b < 2; ++b)
#pragma unroll
            for (int m = 0; m < 4; ++m)
#pragma unroll
                for (int n = 0; n < 2; ++n) acc[a][b][m][n] = (f32x4){0.f, 0.f, 0.f, 0.f};
    bf16x8 At[4][2], B0[2][2], B1[2][2];
    const char* cA = cur.A; const char* cB = cur.B;
    PG8_STAGE(PG8_SB(0, 0), cB, voffB); PG8_STAGE(PG8_SA(0, 0), cA, voffA); PG8_STAGE(PG8_SB(0, 1), cB + hstepB, voffB); PG8_STAGE(PG8_SA(0, 1), cA + hstepA, voffA);
    if (wr == 1) PG8_BAR;
    PG8_WAIT_V(4); PG8_BAR;
    PG8_STAGE(PG8_SB(1, 0), cB + kstep, voffB); PG8_STAGE(PG8_SA(1, 0), cA + kstep, voffA); PG8_STAGE(PG8_SB(1, 1), cB + hstepB + kstep, voffB);
    PG8_WAIT_V(6); PG8_BAR;
    for (;;) {
        const bool has_next = S.next(ui + 1, nxt);
        const char* nA = has_next ? nxt.A : cA; const char* nB = has_next ? nxt.B : cB;
        for (int t = 0; t < nt; t += 2) {
            const bool last = (t == nt - 2);
            const char* a1 = cA + (size_t)(t + 1) * kstep;
            const char* a2 = last ? nA : cA + (size_t)(t + 2) * kstep; const char* b2 = last ? nB : cB + (size_t)(t + 2) * kstep;
            const char* a3 = a2 + kstep; const char* b3 = b2 + kstep;
            PG8_LDB(B0, 0, 0); PG8_SCHED; PG8_LDA(At, 0, 0); PG8_STAGE(PG8_SA(1, 1), a1 + hstepA, voffA);
            PG8_WAIT_L(8); PG8_BAR; PG8_WAIT_L(0); PG8_MMA(0, 0, At, B0); PG8_BAR; PG8_SCHED;
            PG8_LDB(B1, 0, 1); PG8_STAGE(PG8_SB(0, 0), b2, voffB);
            PG8_BAR; PG8_WAIT_L(0); PG8_MMA(0, 1, At, B1); PG8_BAR;
            PG8_LDA(At, 0, 1); PG8_STAGE(PG8_SA(0, 0), a2, voffA);
            PG8_BAR; PG8_WAIT_L(0); PG8_MMA(1, 0, At, B0); PG8_BAR; PG8_SCHED;
            PG8_STAGE(PG8_SB(0, 1), b2 + hstepB, voffB);
            PG8_WAIT_V(6); PG8_BAR; PG8_MMA(1, 1, At, B1); PG8_BAR;
            PG8_LDB(B0, 1, 0); PG8_SCHED; PG8_LDA(At, 1, 0); PG8_STAGE(PG8_SA(0, 1), a2 + hstepA, voffA);
            PG8_WAIT_L(8); PG8_BAR; PG8_WAIT_L(0); PG8_MMA(0, 0, At, B0); PG8_BAR; PG8_SCHED;
            PG8_LDB(B1, 1, 1); PG8_STAGE(PG8_SB(1, 0), b3, voffB);
            PG8_BAR; PG8_WAIT_L(0); PG8_MMA(0, 1, At, B1); PG8_BAR;
            PG8_LDA(At, 1, 1); PG8_STAGE(PG8_SA(1, 0), a3, voffA);
            PG8_BAR; PG8_WAIT_L(0); PG8_MMA(1, 0, At, B0); PG8_BAR; PG8_SCHED;
            PG8_STAGE(PG8_SB(1, 1), b3 + hstepB, voffB);
            PG8_WAIT_V(6); PG8_BAR; PG8_MMA(1, 1, At, B1); PG8_BAR;
        }
        E(acc, cur, wr, wc, fr, fq);
        if (PROBE_ID == 20 && Epi::PROBE2X) { asm volatile("" ::: "memory"); E(acc, cur, wr, wc, fr, fq); }
        if (!has_next) break;
#pragma unroll
        for (int a = 0; a < 2; ++a)
#pragma unroll
            for (int b = 0; b < 2; ++b)
#pragma unroll
                for (int m = 0; m < 4; ++m)
#pragma unroll
                    for (int n = 0; n < 2; ++n) acc[a][b][m][n] = (f32x4){0.f, 0.f, 0.f, 0.f};
        cur = nxt; cA = nA; cB = nB; ++ui;
    }
    PG8_WAIT_V(0);
    if (wr == 0) PG8_BAR;
    PG8_BAR;
#undef PG8_SA
#undef PG8_SB
#undef PG8_STAGE
#undef PG8_LDA
#undef PG8_LDB
#undef PG8_MMA
#undef PG8_WAIT_V
#undef PG8_WAIT_L
#undef PG8_BAR
#undef PG8_SCHED
}

typedef f32x4 AccT[2][2][4][2];

struct EpiIn {
    static constexpr bool PERM = true, PROBE2X = false;
    bf16_t* us5; bf16_t* xg;
    __device__ __forceinline__ void operator()(const AccT& acc, const Unit& u, int wr, int wc, int fr, int fq) const {
#pragma unroll
        for (int ai = 0; ai < 2; ++ai)
#pragma unroll
            for (int m = 0; m < 4; ++m) {
                const int row = u.pm * BM + ai * HALF + wr * 64 + m * 16 + fr;
#pragma unroll
                for (int bj = 0; bj < 2; ++bj) {
                    const int col0 = u.pn * BM + bj * HALF + wc * 32 + 8 * fq;
                    const f32x4 v0 = acc[ai][bj][m][0], v1 = acc[ai][bj][m][1];
                    u32x4 w; w.x = cvt_pk_bf16(v0[0], v0[1]); w.y = cvt_pk_bf16(v0[2], v0[3]); w.z = cvt_pk_bf16(v1[0], v1[1]); w.w = cvt_pk_bf16(v1[2], v1[3]);
                    if (u.pn < 2) { const int g = col0 >> 4, p0 = col0 & 15, mr = row >> 5, s = row & 31;
                        *(u32x4*)(us5 + ((size_t)g * MSP + mr) * K3 + s * 16 + p0) = w; }
                    else *(u32x4*)(xg + (size_t)row * 1024 + (col0 - 512)) = w;
                }
            }
    }
};
struct EpiHloc {
    static constexpr bool PERM = false, PROBE2X = false;
    float* hloc;
    __device__ __forceinline__ void operator()(const AccT& acc, const Unit& u, int wr, int wc, int fr, int fq) const {
#pragma unroll
        for (int ai = 0; ai < 2; ++ai)
#pragma unroll
            for (int m = 0; m < 4; ++m) {
                const int row = u.pm * BM + ai * HALF + wr * 64 + m * 16 + fr;
                if (row < MS) {
                    float* rp = hloc + ((size_t)u.g * MS + row) * 256 + wc * 32 + 4 * fq;
#pragma unroll
                    for (int bj = 0; bj < 2; ++bj)
#pragma unroll
                        for (int n = 0; n < 2; ++n) *(f32x4*)(rp + bj * HALF + n * 16) = acc[ai][bj][m][n];
                }
            }
    }
};
struct EpiY1 {
    static constexpr bool PERM = true, PROBE2X = false;
    bf16_t* y1;
    __device__ __forceinline__ void operator()(const AccT& acc, const Unit& u, int wr, int wc, int fr, int fq) const {
#pragma unroll
        for (int ai = 0; ai < 2; ++ai)
#pragma unroll
            for (int m = 0; m < 4; ++m) {
                const int row = u.pm * BM + ai * HALF + wr * 64 + m * 16 + fr;
                if (row < MS) {
#pragma unroll
                    for (int bj = 0; bj < 2; ++bj) {
                        const int col0 = u.pn * BM + bj * HALF + wc * 32 + 8 * fq, t = col0 >> 4, q0 = col0 & 15;
                        const f32x4 v0 = acc[ai][bj][m][0], v1 = acc[ai][bj][m][1];
                        u32x4 w; w.x = cvt_pk_bf16(gelu_tanh(v0[0]), gelu_tanh(v0[1])); w.y = cvt_pk_bf16(gelu_tanh(v0[2]), gelu_tanh(v0[3]));
                        w.z = cvt_pk_bf16(gelu_tanh(v1[0]), gelu_tanh(v1[1])); w.w = cvt_pk_bf16(gelu_tanh(v1[2]), gelu_tanh(v1[3]));
                        *(u32x4*)(y1 + ((size_t)row * TS + t) * 512 + u.g * 16 + q0) = w;
                    }
                }
            }
    }
};
struct EpiGlu {
    static constexpr bool PERM = true, PROBE2X = false;
    const bf16_t* y1; bf16_t* y; const float* bias;
    __device__ __forceinline__ void operator()(const AccT& acc, const Unit& u, int wr, int wc, int fr, int fq) const {
#pragma unroll
        for (int bj = 0; bj < 2; ++bj) {
            const int col0 = u.pn * BM + bj * HALF + wc * 32 + 8 * fq;
            const f32x4 b0 = *(const f32x4*)(bias + col0), b1 = *(const f32x4*)(bias + col0 + 4);
#pragma unroll
            for (int ai = 0; ai < 2; ++ai)
#pragma unroll
                for (int m = 0; m < 4; ++m) {
                    const int row = u.pm * BM + ai * HALF + wr * 64 + m * 16 + fr;
                    const u32x4 yv = *(const u32x4*)(y1 + (size_t)row * 512 + col0);
                    const f32x4 v0 = acc[ai][bj][m][0] + b0, v1 = acc[ai][bj][m][1] + b1;
                    u32x4 w;
                    w.x = cvt_pk_bf16(bf_lo(yv.x) * sigmoidf_(v0[0]), bf_hi(yv.x) * sigmoidf_(v0[1]));
                    w.y = cvt_pk_bf16(bf_lo(yv.y) * sigmoidf_(v0[2]), bf_hi(yv.y) * sigmoidf_(v0[3]));
                    w.z = cvt_pk_bf16(bf_lo(yv.z) * sigmoidf_(v1[0]), bf_hi(yv.z) * sigmoidf_(v1[1]));
                    w.w = cvt_pk_bf16(bf_lo(yv.w) * sigmoidf_(v1[2]), bf_hi(yv.w) * sigmoidf_(v1[3]));
                    *(u32x4*)(y + (size_t)row * 1024 + col0) = w;
                }
        }
    }
};
struct EpiOut {
    static constexpr bool PERM = true, PROBE2X = false;
    bf16_t* o; float* rowss;
    __device__ __forceinline__ void operator()(const AccT& acc, const Unit& u, int wr, int wc, int fr, int fq) const {
#pragma unroll
        for (int ai = 0; ai < 2; ++ai)
#pragma unroll
            for (int m = 0; m < 4; ++m) {
                const int row = u.pm * BM + ai * HALF + wr * 64 + m * 16 + fr;
                float s = 0.f;
#pragma unroll
                for (int bj = 0; bj < 2; ++bj) {
                    const int col0 = u.pn * BM + bj * HALF + wc * 32 + 8 * fq;
                    const f32x4 v0 = acc[ai][bj][m][0], v1 = acc[ai][bj][m][1];
                    s += (v0[0] * v0[0] + v0[1] * v0[1]) + (v0[2] * v0[2] + v0[3] * v0[3]) + (v1[0] * v1[0] + v1[1] * v1[1]) + (v1[2] * v1[2] + v1[3] * v1[3]);
                    u32x4 w; w.x = cvt_pk_bf16(v0[0], v0[1]); w.y = cvt_pk_bf16(v0[2], v0[3]); w.z = cvt_pk_bf16(v1[0], v1[1]); w.w = cvt_pk_bf16(v1[2], v1[3]);
                    *(u32x4*)(o + (size_t)row * 1024 + col0) = w;
                }
                s += __shfl_xor(s, 16); s += __shfl_xor(s, 32);
                if (fq == 0) rowss[(size_t)row * 16 + u.pn * 4 + wc] = s;
            }
    }
};
struct EpiOutPub {
    static constexpr bool PERM = true, PROBE2X = false;
    bf16_t* o; float* rowss; unsigned* cnt;
    __device__ __forceinline__ void operator()(const AccT& acc, const Unit& u, int wr, int wc, int fr, int fq) const {
#pragma unroll
        for (int ai = 0; ai < 2; ++ai)
#pragma unroll
            for (int m = 0; m < 4; ++m) {
                const int row = u.pm * BM + ai * HALF + wr * 64 + m * 16 + fr;
#pragma unroll
                for (int bj = 0; bj < 2; ++bj) {
                    const int col0 = u.pn * BM + bj * HALF + wc * 32 + 8 * fq;
                    const f32x4 v0 = acc[ai][bj][m][0], v1 = acc[ai][bj][m][1];
                    u32x4 w; w.x = cvt_pk_bf16(v0[0], v0[1]); w.y = cvt_pk_bf16(v0[2], v0[3]); w.z = cvt_pk_bf16(v1[0], v1[1]); w.w = cvt_pk_bf16(v1[2], v1[3]);
                    st16_wt(o + (size_t)row * 1024 + col0, w);
                }
            }
        asm volatile("s_waitcnt vmcnt(0)" ::: "memory");
        if (fr == 0 && fq == 0) (void)__hip_atomic_fetch_add(cnt + u.pm, 1u, __ATOMIC_RELAXED, __HIP_MEMORY_SCOPE_AGENT);
    }
};
struct PanelOrder {
    const char* A; const char* B; size_t tA, tB; int np, G, c, skip;
    __device__ void init(const void* A_, int lda, const void* B_, int ldb, int G_, int c_, int skipctx) {
        A = (const char*)A_; B = (const char*)B_; tA = (size_t)BM * lda * 2; tB = (size_t)BM * ldb * 2; skip = skipctx; np = skipctx ? NB * 16 : MTOK / BM; G = G_; c = c_; }
    __device__ __forceinline__ int panel(int p) const { return skip ? p + (p >> 4) + 1 : p; }
    __device__ __forceinline__ bool next(int i, Unit& u) const {
        int p, pn;
        if (G == 256) {
            const int x = c & 7, j = c >> 3, rem = np - i * 64; if (rem <= 0) return false;
            const int ppx = rem >= 64 ? 8 : (rem + 7) >> 3;
            if ((j >> 2) >= ppx) return false;
            p = i * 64 + x * ppx + (j >> 2); pn = j & 3; if (p >= np) return false;
        } else { const long L = (long)i * G + c; if (L >= (long)np * 4) return false; p = (int)L >> 2; pn = (int)L & 3; }
        u.pm = panel(p); u.pn = pn; u.g = 0;
        u.A = A + (size_t)u.pm * tA; u.B = B + (size_t)u.pn * tB; return true;
    }
};
struct EpiFfn {
    static constexpr bool PERM = true, PROBE2X = true;
    bf16_t* aff;
    __device__ __forceinline__ void operator()(const AccT& acc, const Unit& u, int wr, int wc, int fr, int fq) const {
#pragma unroll
        for (int ai = 0; ai < 2; ++ai)
#pragma unroll
            for (int m = 0; m < 4; ++m) {
                const int row = u.pm * BM + ai * HALF + wr * 64 + m * 16 + fr;
                const f32x4 g0 = acc[ai][0][m][0], g1 = acc[ai][0][m][1], u0 = acc[ai][1][m][0], u1 = acc[ai][1][m][1];
                u32x4 w;
                w.x = cvt_pk_bf16(siluf_(g0[0]) * u0[0], siluf_(g0[1]) * u0[1]); w.y = cvt_pk_bf16(siluf_(g0[2]) * u0[2], siluf_(g0[3]) * u0[3]);
                w.z = cvt_pk_bf16(siluf_(g1[0]) * u1[0], siluf_(g1[1]) * u1[1]); w.w = cvt_pk_bf16(siluf_(g1[2]) * u1[2], siluf_(g1[3]) * u1[3]);
                *(u32x4*)(aff + (size_t)row * DFF + u.pn * 128 + wc * 32 + 8 * fq) = w;
            }
    }
};

__device__ __forceinline__ void phase_mod(KArgP a, unsigned char* ws, LAS unsigned char* lds, int first, int step) {
    const int tid = fresh_tid(), lane = tid & 63, wv = tid >> 6;
    LAS float* sc = (LAS float*)lds;
    LAS float* red = sc + 9216;
    for (int idx = tid; idx < 9216; idx += 512) { const int bb = idx >> 10, k = idx & 1023; const float v = bb < 8 ? a->in[1][bb * 1024 + k] : a->in[3][k]; sc[idx] = siluf_(v); }
    __syncthreads();
    float* mod = (float*)(ws + WS_MOD);
    for (int u = first; u < 384; u += step) {
        const int l = u / 96, jg = u % 96, j = jg * 64 + lane;
        const float* w = a->in[4] + ((size_t)l * 1024 + wv * 128) * 6144 + j;
        float acc[9];
#pragma unroll
        for (int bb = 0; bb < 9; ++bb) acc[bb] = 0.f;
        for (int k0 = 0; k0 < 128; k0 += 16) {
            float wv8[16];
#pragma unroll
            for (int e = 0; e < 16; ++e) wv8[e] = __builtin_nontemporal_load(w + (size_t)(k0 + e) * 6144);
#pragma unroll
            for (int e = 0; e < 16; ++e)
#pragma unroll
                for (int bb = 0; bb < 9; ++bb) acc[bb] += sc[bb * 1024 + wv * 128 + k0 + e] * wv8[e];
        }
#pragma unroll
        for (int bb = 0; bb < 9; ++bb) red[(wv * 9 + bb) * 64 + lane] = acc[bb];
        __syncthreads();
        for (int o = tid; o < 576; o += 512) { const int bb = o >> 6, ln = o & 63; float s = a->in[5][l * 6144 + jg * 64 + ln];
#pragma unroll
            for (int w8 = 0; w8 < 8; ++w8) s += red[(w8 * 9 + bb) * 64 + ln];
            mod[((size_t)l * 9 + bb) * 6144 + jg * 64 + ln] = s; }
        __syncthreads();
    }
}

__device__ __forceinline__ void transpose_tile(const float* src, int N, bf16_t* dst, int Kd, int k0, int n0, int drow0, LAS float* t) {
    const int tid = fresh_tid();
#pragma unroll
    for (int i = 0; i < 16; ++i) { const int k = i * 8 + (tid >> 6), n = tid & 63; t[k * 65 + n] = src[(size_t)(k0 + k) * N + n0 + n]; }
    __syncthreads();
#pragma unroll
    for (int i = 0; i < 8; ++i) { const int n = i * 8 + (tid >> 6), kk = (tid & 63) * 2;
        *(unsigned*)(dst + (size_t)(drow0 + n) * Kd + k0 + kk) = cvt_pk_bf16(t[kk * 65 + n], t[(kk + 1) * 65 + n]); }
    __syncthreads();
}
__device__ __forceinline__ void phase_wconv(KArgP a, unsigned char* ws, LAS unsigned char* lds, int l, int first, int step) {
    LAS float* t = (LAS float*)lds;
    for (int T = first; T < 1408; T += step) {
        int r = T;
        unsigned char* wl = ws + WS_WL + (size_t)(l & 1) * WL_SIZE;
        if (r < 192) { const int kt = r / 24, nt = r % 24; transpose_tile(a->in[7] + (size_t)l * 1024 * 1536, 1536, (bf16_t*)(wl + WL_IN), 1024, kt * 128, nt * 64, nt * 64, t); }
        else if (r < 224) { r -= 192; const int kt = r / 8, nt = r % 8; transpose_tile(a->in[16] + (size_t)l * 512 * 512, 512, (bf16_t*)(wl + WL_GLU), 512, kt * 128, nt * 64, nt * 64, t); }
        else if (r < 352) { r -= 224; const int kt = r / 16, nt = r % 16; transpose_tile(a->in[25] + (size_t)l * 1024 * 1024, 1024, (bf16_t*)(wl + WL_OUT), 1024, kt * 128, nt * 64, nt * 64, t); }
        else if (r < 1056) { r -= 352; const int kt = r / 88, nt = r % 88; const int n0 = nt * 64;
            const int drow0 = n0 < DFF ? 256 * (n0 / 128) + (n0 % 128) : 256 * ((n0 - DFF) / 128) + 128 + ((n0 - DFF) % 128);
            transpose_tile(a->in[26] + (size_t)l * 1024 * 5632, 5632, (bf16_t*)(wl + WL_FI), 1024, kt * 128, n0, drow0, t); }
        else { r -= 1056; const int kt = r / 16, nt = r % 16; transpose_tile(a->in[27] + (size_t)l * DFF * 1024, 1024, (bf16_t*)(wl + WL_FO), DFF, kt * 128, nt * 64, nt * 64, t); }
    }
    for (int idx = first * 512 + fresh_tid(); idx < 8 * 4 * 64 * 64; idx += step * 512) {
        const int j = idx & 63, k = (idx >> 6) & 63, nb = (idx >> 12) & 3, h = (idx >> 14) & 7;
        const float* src = (nb & 1) ? a->in[22] : a->in[20];
        const float v = src[((((size_t)l * 2 + (nb >> 1)) * 8 + h) * 64 + k) * 64 + j];
        bf16_t* dst = (bf16_t*)(ws + WS_WL + (size_t)(l & 1) * WL_SIZE + WL_LRU);
        dst[((size_t)h * 256 + nb * 64 + j) * 64 + k] = (bf16_t)(cvt_pk_bf16(v, 0.f) & 0xffffu);
    }
}

__device__ __forceinline__ void s5tab_group(KArgP a, unsigned char* ws, LAS unsigned char* lds, int layer, int g) {
    const int tid = fresh_tid();
    LAS f32x2* abp = (LAS f32x2*)lds;
    LAS f32x2* bbv = (LAS f32x2*)(lds + 33792);
    LAS f32x2* ccv = (LAS f32x2*)(lds + 50176);
    LAS float* kt = (LAS float*)(lds + 67584);
    LAS float* dl = (LAS float*)(lds + 133120);
    if (tid < 16) dl[tid] = a->in[15][layer * 512 + g * 16 + tid];
    {
        const int d = tid >> 8, n = (tid >> 2) & 63, jq = tid & 3, base = (layer * 2 + d) * 32 + g;
        const float dt = expf(a->in[10][base]);
        const float are = a->in[8][base * 64 + n], aim = a->in[9][base * 64 + n];
        const float zr = are * dt; float rev = aim * dt * 0.15915494309189535f; rev -= rintf(rev); const float zi = rev * 6.283185307179586f;
        const float em1 = expm1f(zr), cz = cosf(zi), sz = sinf(zi), s2 = sinf(0.5f * zi);
        const float a1r = (em1 + 1.f) * cz, a1i = (em1 + 1.f) * sz;
        float t2r = a1r * a1r - a1i * a1i, t2i = 2.f * a1r * a1i;
        float t4r = t2r * t2r - t2i * t2i, t4i = 2.f * t2r * t2i;
        const float a8r = t4r * t4r - t4i * t4i, a8i = 2.f * t4r * t4i;
        float pr = 1.f, pi = 0.f;
        for (int k = 0; k < jq; ++k) { const float nr_ = pr * a8r - pi * a8i, ni_ = pr * a8i + pi * a8r; pr = nr_; pi = ni_; }
        if (jq == 0) { float o1 = 1.f, o0 = 0.f; asm volatile("" : "+v"(o1), "+v"(o0)); abp[(d * 64 + n) * 33] = mk2(o1, o0); }
#pragma unroll
        for (int k = 1; k <= 8; ++k) { const float nr_ = pr * a1r - pi * a1i, ni_ = pr * a1i + pi * a1r; pr = nr_; pi = ni_; abp[(d * 64 + n) * 33 + 8 * jq + k] = mk2(pr, pi); }
        if (jq == 3) ((f32x2*)(ws + WS_AT))[(g * 2 + d) * 64 + n] = mk2(pr, pi);
        const float nr = em1 * cz - 2.f * s2 * s2, abim = a1i;
        const float den = are * are + aim * aim;
        const float fre = (nr * are + abim * aim) / den, fim = (abim * are - nr * aim) / den;
#pragma unroll
        for (int pp = 0; pp < 4; ++pp) { const int p = jq * 4 + pp;
            const float br = a->in[11][((size_t)base * 64 + n) * 16 + p], bi = a->in[12][((size_t)base * 64 + n) * 16 + p];
            bbv[(d * 64 + n) * 16 + p] = mk2(fre * br - fim * bi, fre * bi + fim * br);
            ccv[(d * 64 + n) * 17 + p] = mk2(a->in[13][((size_t)base * 16 + p) * 64 + n], a->in[14][((size_t)base * 16 + p) * 64 + n]); }
    }
    __syncthreads();
    for (int it = 0; it < 2; ++it) {
        const int combo = tid + it * 512, d = combo >> 9, tau = (combo >> 4) & 31, q = combo & 15;
        float acc[16];
#pragma unroll
        for (int p = 0; p < 16; ++p) acc[p] = 0.f;
        for (int n = 0; n < 64; ++n) {
            const f32x2 c = ccv[(d * 64 + n) * 17 + q], pw = abp[(d * 64 + n) * 33 + tau];
            const float wr_ = c.x * pw.x - c.y * pw.y, wi_ = c.x * pw.y + c.y * pw.x;
#pragma unroll
            for (int p = 0; p < 16; p += 2) { const f32x4 bv = *(const LAS f32x4*)(bbv + (d * 64 + n) * 16 + p); acc[p] += wr_ * bv[0] - wi_ * bv[1]; acc[p + 1] += wr_ * bv[2] - wi_ * bv[3]; }
        }
#pragma unroll
        for (int p4 = 0; p4 < 4; ++p4) *(LAS f32x4*)(kt + (((d * 16 + q) * 2 + (p4 >> 1)) * 32 + tau) * 8 + (p4 & 1) * 4) = (f32x4){acc[4 * p4], acc[4 * p4 + 1], acc[4 * p4 + 2], acc[4 * p4 + 3]};
    }
    __syncthreads();
    bf16_t* bt3 = (bf16_t*)(ws + WS_BT3) + (size_t)g * 512 * K3;
    bf16_t* bt1 = (bf16_t*)(ws + WS_BT1) + (size_t)g * 256 * K1;
    for (int i = 0; i < 64; ++i) {
        const int it = tid + 512 * i, row = it >> 6, sidx = (it >> 1) & 31, ph = it & 1, t = row >> 4, q = row & 15;
        const int tf = t - sidx, tr = sidx - t;
        const float mf = tf >= 0 ? 1.f : 0.f, mr = tr >= 0 ? 1.f : 0.f;
        const LAS float* pf = kt + ((q * 2 + ph) * 32 + (tf >= 0 ? tf : 0)) * 8;
        const LAS float* pr_ = kt + (((16 + q) * 2 + ph) * 32 + (tr >= 0 ? tr : 0)) * 8;
        const f32x4 f0 = *(const LAS f32x4*)pf, f1 = *(const LAS f32x4*)(pf + 4), r0 = *(const LAS f32x4*)pr_, r1 = *(const LAS f32x4*)(pr_ + 4);
        const float dq = (sidx == t) ? dl[q] : 0.f; const int qe = q - ph * 8;
        float v[8];
#pragma unroll
        for (int e = 0; e < 4; ++e) { v[e] = mf * f0[e] + mr * r0[e] + (qe == e ? dq : 0.f); v[4 + e] = mf * f1[e] + mr * r1[e] + (qe == 4 + e ? dq : 0.f); }
        u32x4 w; w.x = cvt_pk_bf16(v[0], v[1]); w.y = cvt_pk_bf16(v[2], v[3]); w.z = cvt_pk_bf16(v[4], v[5]); w.w = cvt_pk_bf16(v[6], v[7]);
        *(u32x4*)(bt3 + (size_t)row * K3 + sidx * 16 + ph * 8) = w;
    }
    for (int i = 0; i < 32; ++i) {
        const int it = tid + 512 * i, row = it >> 5, c8 = (it & 31) * 8, t = row >> 4, q = row & 15, d = c8 >> 7, n0 = (c8 & 127) >> 1;
        const int pw = d == 0 ? t + 1 : 32 - t;
        float v[8];
#pragma unroll
        for (int e = 0; e < 4; ++e) { const f32x2 c = ccv[(d * 64 + n0 + e) * 17 + q], pa = abp[(d * 64 + n0 + e) * 33 + pw];
            v[2 * e] = c.x * pa.x - c.y * pa.y; v[2 * e + 1] = -(c.x * pa.y + c.y * pa.x); }
        u32x4 w; w.x = cvt_pk_bf16(v[0], v[1]); w.y = cvt_pk_bf16(v[2], v[3]); w.z = cvt_pk_bf16(v[4], v[5]); w.w = cvt_pk_bf16(v[6], v[7]);
        *(u32x4*)(bt3 + (size_t)row * K3 + 512 + c8) = w;
    }
    for (int i = 0; i < 32; ++i) {
        const int it = tid + 512 * i, row = it >> 6, k8 = (it & 63) * 8, s = k8 >> 4, p0 = k8 & 15, d = row >> 7, n = (row & 127) >> 1, ci = row & 1;
        const int pw = d == 0 ? 31 - s : s;
        const f32x2 pa = abp[(d * 64 + n) * 33 + pw];
        float v[8];
#pragma unroll
        for (int e = 0; e < 8; ++e) { const f32x2 bv = bbv[(d * 64 + n) * 16 + p0 + e]; v[e] = ci ? (pa.x * bv.y + pa.y * bv.x) : (pa.x * bv.x - pa.y * bv.y); }
        u32x4 w; w.x = cvt_pk_bf16(v[0], v[1]); w.y = cvt_pk_bf16(v[2], v[3]); w.z = cvt_pk_bf16(v[4], v[5]); w.w = cvt_pk_bf16(v[6], v[7]);
        *(u32x4*)(bt1 + (size_t)row * K1 + k8) = w;
    }
    __syncthreads();
}

template <int MODE, int NR, bool COH = false>
__device__ __forceinline__ void norm_rows(KArgP a, unsigned char* ws, int layer, int R0, int lane, const float (&cA)[16], const float (&cB)[16], const float (&cC)[16]) {
    const bool from_input = (MODE == 0) || (MODE == 1 && layer == 0);
    const bool final_out = (MODE == 2 && layer == DEPTH - 1);
    float x[NR][16]; u32x4 ov[NR][2]; float rsv[NR]; float* fdst[NR];
#pragma unroll
    for (int r = 0; r < NR; ++r) {
        const int R = R0 + r, b = R / POS, pos = R % POS; const bool isctx = pos < CTXL;
        fdst[r] = a->out + ((size_t)b * SEQ + (isctx ? 0 : pos - CTXL)) * D;
        if (from_input) {
            const float* xsrc = isctx ? a->in[2] + ((size_t)b * CTXL + pos) * D : a->in[0] + ((size_t)b * SEQ + (pos - CTXL)) * D;
#pragma unroll
            for (int i = 0; i < 2; ++i) { const int c0 = lane * 8 + 512 * i; const f32x4 p = *(const f32x4*)(xsrc + c0), q = *(const f32x4*)(xsrc + c0 + 4);
                x[r][8 * i + 0] = p[0]; x[r][8 * i + 1] = p[1]; x[r][8 * i + 2] = p[2]; x[r][8 * i + 3] = p[3]; x[r][8 * i + 4] = q[0]; x[r][8 * i + 5] = q[1]; x[r][8 * i + 6] = q[2]; x[r][8 * i + 7] = q[3]; }
        } else {
            const bf16_t* xb = (const bf16_t*)(ws + WS_XB) + (size_t)R * D;
#pragma unroll
            for (int i = 0; i < 2; ++i) { const u32x4 v = *(const u32x4*)(xb + lane * 8 + 512 * i);
                x[r][8 * i + 0] = h_lo(v.x); x[r][8 * i + 1] = h_hi(v.x); x[r][8 * i + 2] = h_lo(v.y); x[r][8 * i + 3] = h_hi(v.y); x[r][8 * i + 4] = h_lo(v.z); x[r][8 * i + 5] = h_hi(v.z); x[r][8 * i + 6] = h_lo(v.w); x[r][8 * i + 7] = h_hi(v.w); }
        }
        if (MODE != 0) {
            const bf16_t* o = (const bf16_t*)(ws + WS_R3) + (size_t)R * D;
            if (COH) {
                unsigned long long q[4];
#pragma unroll
                for (int k = 0; k < 4; ++k) q[k] = __hip_atomic_load((unsigned long long*)(o + lane * 8 + 512 * (k >> 1) + 4 * (k & 1)), __ATOMIC_RELAXED, __HIP_MEMORY_SCOPE_AGENT);
                ov[r][0] = (u32x4){(unsigned)q[0], (unsigned)(q[0] >> 32), (unsigned)q[1], (unsigned)(q[1] >> 32)};
                ov[r][1] = (u32x4){(unsigned)q[2], (unsigned)(q[2] >> 32), (unsigned)q[3], (unsigned)(q[3] >> 32)};
                rsv[r] = 0.f;
            } else {
            ov[r][0] = *(const u32x4*)(o + lane * 8); ov[r][1] = *(const u32x4*)(o + lane * 8 + 512);
            rsv[r] = ((const float*)(ws + WS_ROWSS))[(size_t)R * 16 + (lane & 15)]; }
        }
    }
#pragma unroll
    for (int r = 0; r < NR; ++r) {
        if (MODE != 0) {
            float ofa[2][8];
#pragma unroll
            for (int i = 0; i < 2; ++i) { const u32x4 v = ov[r][i];
                ofa[i][0] = bf_lo(v.x); ofa[i][1] = bf_hi(v.x); ofa[i][2] = bf_lo(v.y); ofa[i][3] = bf_hi(v.y); ofa[i][4] = bf_lo(v.z); ofa[i][5] = bf_hi(v.z); ofa[i][6] = bf_lo(v.w); ofa[i][7] = bf_hi(v.w); }
            float ss;
            if (COH) {
                ss = 0.f;
#pragma unroll
                for (int i = 0; i < 2; ++i)
#pragma unroll
                    for (int e = 0; e < 8; ++e) ss += ofa[i][e] * ofa[i][e];
#pragma unroll
                for (int off = 32; off >= 1; off >>= 1) ss += __shfl_xor(ss, off);
            } else { ss = rsv[r]; ss += __shfl_xor(ss, 1); ss += __shfl_xor(ss, 2); ss += __shfl_xor(ss, 4); ss += __shfl_xor(ss, 8); }
            const float rstd = rsqrtf(ss * (1.0f / 1024.0f) + EPS);
#pragma unroll
            for (int i = 0; i < 2; ++i) { const float (&of)[8] = ofa[i];
#pragma unroll
                for (int e = 0; e < 8; ++e) x[r][8 * i + e] += cA[8 * i + e] * (of[e] * rstd);
                const int c0 = lane * 8 + 512 * i;
                if (final_out) { *(f32x4*)(fdst[r] + c0) = (f32x4){x[r][8 * i], x[r][8 * i + 1], x[r][8 * i + 2], x[r][8 * i + 3]}; *(f32x4*)(fdst[r] + c0 + 4) = (f32x4){x[r][8 * i + 4], x[r][8 * i + 5], x[r][8 * i + 6], x[r][8 * i + 7]}; }
                else { u32x4 w; w.x = pk_h2(x[r][8 * i], x[r][8 * i + 1]); w.y = pk_h2(x[r][8 * i + 2], x[r][8 * i + 3]); w.z = pk_h2(x[r][8 * i + 4], x[r][8 * i + 5]); w.w = pk_h2(x[r][8 * i + 6], x[r][8 * i + 7]);
                    *(u32x4*)((bf16_t*)(ws + WS_XB) + (size_t)(R0 + r) * D + c0) = w; } }
        }
        if (!(MODE == 2 && layer == DEPTH - 1)) {
            float s2 = 0.f;
#pragma unroll
            for (int e = 0; e < 16; ++e) s2 += x[r][e] * x[r][e];
#pragma unroll
            for (int off = 32; off >= 1; off >>= 1) s2 += __shfl_xor(s2, off);
            const float rstd2 = rsqrtf(s2 * (1.0f / 1024.0f) + EPS);
            bf16_t* h = (bf16_t*)(ws + WS_R2) + (size_t)(R0 + r) * D;
#pragma unroll
            for (int i = 0; i < 2; ++i) { float hv[8];
#pragma unroll
                for (int e = 0; e < 8; ++e) hv[e] = (x[r][8 * i + e] * rstd2) * cB[8 * i + e] + cC[8 * i + e];
                u32x4 w; w.x = cvt_pk_bf16(hv[0], hv[1]); w.y = cvt_pk_bf16(hv[2], hv[3]); w.z = cvt_pk_bf16(hv[4], hv[5]); w.w = cvt_pk_bf16(hv[6], hv[7]);
                *(u32x4*)(h + lane * 8 + 512 * i) = w; }
        }
    }
}
template <int MODE>
__device__ __forceinline__ void norm_params(KArgP a, unsigned char* ws, int layer, int cb, int lane, float (&cA)[16], float (&cB)[16], float (&cC)[16]) {
    const float* mod = (const float*)(ws + WS_MOD);
    const float* gains = a->in[6];
    const int ln = MODE == 2 ? layer + 1 : layer;
    const float* gate = mod + ((size_t)layer * 9 + cb) * 6144 + (MODE == 1 ? 2 : 5) * 1024;
    const float* gpost = gains + ((size_t)layer * 4 + (MODE == 1 ? 1 : 3)) * 1024;
    const float* gpre = gains + ((size_t)(ln < DEPTH ? ln : 0) * 4 + (MODE == 1 ? 2 : 0)) * 1024;
    const float* shp = mod + ((size_t)(ln < DEPTH ? ln : 0) * 9 + cb) * 6144 + (MODE == 1 ? 3 : 0) * 1024;
    const float* scp = shp + 1024;
#pragma unroll
    for (int i = 0; i < 2; ++i)
#pragma unroll
        for (int e = 0; e < 8; ++e) { const int c = lane * 8 + 512 * i + e;
            if (MODE != 0) cA[8 * i + e] = gate[c] * gpost[c];
            cB[8 * i + e] = gpre[c] * (1.f + scp[c]); cC[8 * i + e] = shp[c]; }
}
template <int MODE>
__device__ __forceinline__ void phase_norm(KArgP a, unsigned char* ws, int layer) {
    const int tid = fresh_tid();
    const int lane = tid & 63, wid = tid >> 6;
    const int gw = fresh_bid() * 8 + wid, GW = gridDim.x * 8;
    const float* mod = (const float*)(ws + WS_MOD);
    const float* gains = a->in[6];
    const int rpw = (MTOK + GW - 1) / GW;
    int R = gw * rpw; const int Rend = (R + rpw) < MTOK ? (R + rpw) : MTOK;
    int cur_cb = -1;
    float cA[16], cB[16], cC[16];
#pragma unroll
    for (int e = 0; e < 16; ++e) { cA[e] = 0.f; cB[e] = 0.f; cC[e] = 0.f; }
    while (R < Rend) {
        const int b = R / POS, pos = R % POS, cb = pos < CTXL ? 8 : b;
        int n = Rend - R; if (n > 4) n = 4;
        { const int Rl = R + n - 1, bl = Rl / POS, pl = Rl % POS, cbl = pl < CTXL ? 8 : bl; if (cbl != cb) n = 1; }
        if (MODE != 0 && layer == DEPTH - 1 && cb == 8) { R += n; continue; }
        if (cb != cur_cb) {
            cur_cb = cb;
            const int ln = MODE == 2 ? layer + 1 : layer;
            const float* gate = mod + ((size_t)layer * 9 + cb) * 6144 + (MODE == 1 ? 2 : 5) * 1024;
            const float* gpost = gains + ((size_t)layer * 4 + (MODE == 1 ? 1 : 3)) * 1024;
            const float* gpre = gains + ((size_t)(ln < DEPTH ? ln : 0) * 4 + (MODE == 1 ? 2 : 0)) * 1024;
            const float* shp = mod + ((size_t)(ln < DEPTH ? ln : 0) * 9 + cb) * 6144 + (MODE == 1 ? 3 : 0) * 1024;
            const float* scp = shp + 1024;
#pragma unroll
            for (int i = 0; i < 2; ++i)
#pragma unroll
                for (int e = 0; e < 8; ++e) { const int c = lane * 8 + 512 * i + e;
                    if (MODE != 0) cA[8 * i + e] = gate[c] * gpost[c];
                    cB[8 * i + e] = gpre[c] * (1.f + scp[c]); cC[8 * i + e] = shp[c]; }
        }
        if (n == 4) { norm_rows<MODE, 4>(a, ws, layer, R, lane, cA, cB, cC); R += 4; }
        else { norm_rows<MODE, 1>(a, ws, layer, R, lane, cA, cB, cC); R += 1; }
    }
}

template <int MODE>
__device__ __forceinline__ void norm_tasks(KArgP a, unsigned char* ws, LAS unsigned char* lds, int layer, unsigned* ctr, int skipctx) {
    const int tid = fresh_tid(), lane = tid & 63, wid = tid >> 6;
    volatile LAS unsigned* tq = (volatile LAS unsigned*)lds;
    const unsigned ntask = (skipctx ? NB * 16 : MTOK / BM) * 4;
    float cA[16], cB[16], cC[16];
#pragma unroll
    for (int e = 0; e < 16; ++e) { cA[e] = 0.f; cB[e] = 0.f; cC[e] = 0.f; }
    int cur_cb = -1;
    for (;;) {
        __syncthreads();
        if (tid == 0) {
            const unsigned t = __hip_atomic_fetch_add(ctr + 200, 1u, __ATOMIC_RELAXED, __HIP_MEMORY_SCOPE_AGENT);
            if (t < ntask) {
                const int p = (int)(t >> 2), pm = skipctx ? p + (p >> 4) + 1 : p;
                unsigned sp = 0;
                while (__hip_atomic_load(ctr + pm, __ATOMIC_RELAXED, __HIP_MEMORY_SCOPE_AGENT) < 32u) { __builtin_amdgcn_s_sleep(2); if (++sp > (1u << 24)) break; }
            }
            tq[0] = t;
        }
        __syncthreads();
        const unsigned t = tq[0];
        if (t >= ntask) break;
        const int p = (int)(t >> 2), pm = skipctx ? p + (p >> 4) + 1 : p;
        const int b = pm / 17, cb = (pm % 17 == 0) ? 8 : b;
        if (cb != cur_cb) { cur_cb = cb; norm_params<MODE>(a, ws, layer, cb, lane, cA, cB, cC); }
        const int R0 = pm * BM + (int)(t & 3) * 64 + wid * 8;
        norm_rows<MODE, 4, true>(a, ws, layer, R0, lane, cA, cB, cC);
        norm_rows<MODE, 4, true>(a, ws, layer, R0 + 4, lane, cA, cB, cC);
    }
    __syncthreads();
}

__device__ __forceinline__ int lru_tok(int b, int cl, int j) {
    if (cl < 4) { const int p = cl * 64 + j; return (p >= 0 && p < CTXL) ? b * POS + p : -1; }
    const int jj = (cl - 4) * 64 + j; if (jj < 0 || jj >= SEQ) return -1;
    return b * POS + CTXL + (jj & 63) * 64 + (jj >> 6);
}
template <int D>
__device__ __forceinline__ void lru_epi_scan(const f32x4 (&acc)[2][4], float brg, float big, float sp, const LAS float* xcf, LAS float* Hs, LAS float* Ps, int ch, int fq, int lane, float& Atot, float& Htot) {
    float hl[4][4], pl[4][4];
    float cA = 1.f, cH = 0.f;
#pragma unroll
    for (int mi = 0; mi < 4; ++mi) {
        const int m = D ? 3 - mi : mi;
        float av[4], bv[4];
#pragma unroll
        for (int rg = 0; rg < 4; ++rg) {
            const int t = 16 * m + 4 * fq + rg;
            const float r = __builtin_amdgcn_rcpf(1.0f + __builtin_amdgcn_exp2f(__builtin_fmaf(acc[0][m][rg], -1.4426950408889634f, brg)));
            const float ig = __builtin_amdgcn_rcpf(1.0f + __builtin_amdgcn_exp2f(__builtin_fmaf(acc[1][m][rg], -1.4426950408889634f, big)));
            av[rg] = __builtin_amdgcn_exp2f(r * sp);
            const float om = __builtin_fmaf(-av[rg], av[rg], 1.0f);
            bv[rg] = __builtin_amdgcn_sqrtf(om) * ig * xcf[t * 64 + ch];
        }
        float H = 0.f, P = 1.f;
#pragma unroll
        for (int qi = 0; qi < 4; ++qi) { const int rg = D ? 3 - qi : qi; H = av[rg] * H + bv[rg]; P *= av[rg]; hl[m][rg] = H; pl[m][rg] = P; }
        float A = P, Hh = H;
        { const float A1 = __shfl(A, D ? lane + 16 : lane - 16), H1 = __shfl(Hh, D ? lane + 16 : lane - 16); const bool ok = D ? (fq <= 2) : (fq >= 1); if (ok) { Hh = A * H1 + Hh; A = A1 * A; } }
        { const float A2 = __shfl(A, D ? lane + 32 : lane - 32), H2 = __shfl(Hh, D ? lane + 32 : lane - 32); const bool ok = D ? (fq <= 1) : (fq >= 2); if (ok) { Hh = A * H2 + Hh; A = A2 * A; } }
        float Ae = __shfl(A, D ? lane + 16 : lane - 16), He = __shfl(Hh, D ? lane + 16 : lane - 16);
        if (D ? (fq == 3) : (fq == 0)) { Ae = 1.f; He = 0.f; }
        const float At = __shfl(A, (lane & 15) + (D ? 0 : 48)), Ht = __shfl(Hh, (lane & 15) + (D ? 0 : 48));
        const float Pin = cA * Ae, Hin = Ae * cH + He;
#pragma unroll
        for (int rg = 0; rg < 4; ++rg) { hl[m][rg] += pl[m][rg] * Hin; pl[m][rg] *= Pin; }
        cH = At * cH + Ht; cA *= At;
    }
    Atot = cA; Htot = cH;
#pragma unroll
    for (int m = 0; m < 4; ++m)
#pragma unroll
        for (int rg = 0; rg < 4; ++rg) { const int t = 16 * m + 4 * fq + rg; Hs[t * 68 + ch] = hl[m][rg]; Ps[t * 68 + ch] = pl[m][rg]; }
}
__device__ __forceinline__ void lru_prefetch(const bf16_t* xg, int U, int tid, u32x4& p0, u32x4& p1, u32x4& pg) {
    const int head = U & 7, bc = U >> 3, b = bc / LCH, cl = bc % LCH;
    const int c8 = (tid & 7) * 8;
    { const int tok = lru_tok(b, cl, (tid >> 3) - 2); p0 = (u32x4){0u, 0u, 0u, 0u}; if (tok >= 0) p0 = *(const u32x4*)(xg + (size_t)tok * 1024 + head * 64 + c8); }
    p1 = (u32x4){0u, 0u, 0u, 0u};
    if (tid < 24) { const int tok = lru_tok(b, cl, 64 + (tid >> 3) - 2); if (tok >= 0) p1 = *(const u32x4*)(xg + (size_t)tok * 1024 + head * 64 + c8); }
    { const int tok = lru_tok(b, cl, tid >> 3); pg = *(const u32x4*)(xg + (size_t)tok * 1024 + 512 + head * 64 + c8); }
}
__device__ __forceinline__ void phase_lru(KArgP a, unsigned char* ws, LAS unsigned char* lds, int layer) {
    const int tid = fresh_tid(), lane = tid & 63, wv = tid >> 6, bid = fresh_bid();
    LAS float* xr_s = (LAS float*)lds;
    LAS float* xcf = (LAS float*)(lds + 17408);
    LAS bf16_t* xcb = (LAS bf16_t*)(lds + 33792);
    LAS float* Hs = (LAS float*)(lds + 43008);
    LAS float* Ps = (LAS float*)(lds + 77824);
    const bf16_t* xg = (const bf16_t*)(ws + WS_XG);
    const int total = NB * LCH * NH;
    const int t_ = tid >> 3, c8 = (tid & 7) * 8;
    const int d = wv >> 2, cbk = wv & 3, fr = lane & 15, fq = lane >> 4, ch = cbk * 16 + fr;
    int cur_head = -1;
    float cw[4][8], cbias[8], brg = 0.f, big = 0.f, sp = 0.f;
    bf16x8 Bf[2][2];
    u32x4 p0, p1, pg;
    int U, ustep, uend;
    if (gridDim.x == 256) { if (bid < 160) { U = bid; ustep = 160; uend = 2400; } else { U = 2400 + (bid - 160); ustep = 96; uend = total; } }
    else { U = (int)gridDim.x - 1 - bid; ustep = (int)gridDim.x; uend = total; }
    if (U < uend) lru_prefetch(xg, U, tid, p0, p1, pg);
    while (U < uend) {
        const int head = U & 7, bc = U >> 3, b = bc / LCH, cl = bc % LCH;
        if (head != cur_head) {
            cur_head = head;
#pragma unroll
            for (int k = 0; k < 4; ++k) { const float* p = a->in[18] + ((size_t)layer * 4 + k) * 512 + head * 64 + c8; const f32x4 u0 = *(const f32x4*)p, u1 = *(const f32x4*)(p + 4);
                cw[k][0] = u0[0]; cw[k][1] = u0[1]; cw[k][2] = u0[2]; cw[k][3] = u0[3]; cw[k][4] = u1[0]; cw[k][5] = u1[1]; cw[k][6] = u1[2]; cw[k][7] = u1[3]; }
            { const float* p = a->in[19] + layer * 512 + head * 64 + c8; const f32x4 u0 = *(const f32x4*)p, u1 = *(const f32x4*)(p + 4);
                cbias[0] = u0[0]; cbias[1] = u0[1]; cbias[2] = u0[2]; cbias[3] = u0[3]; cbias[4] = u1[0]; cbias[5] = u1[1]; cbias[6] = u1[2]; cbias[7] = u1[3]; }
            const bf16_t* Wl = (const bf16_t*)(ws + WS_WL + (size_t)(layer & 1) * WL_SIZE + WL_LRU) + (size_t)head * 256 * 64;
#pragma unroll
            for (int gt = 0; gt < 2; ++gt)
#pragma unroll
                for (int ks = 0; ks < 2; ++ks) Bf[gt][ks] = *(const bf16x8*)(Wl + (size_t)((d * 2 + gt) * 64 + ch) * 64 + ks * 32 + fq * 8);
            const int pidx = (layer * 2 + d) * 512 + head * 64 + ch;
            brg = -1.4426950408889634f * a->in[21][pidx]; big = -1.4426950408889634f * a->in[23][pidx];
            const float ex = __expf(-a->in[24][pidx]);
            sp = ex < 0.1f ? ex * (1.f - ex * (0.5f - ex * (0.33333333f - ex * 0.25f))) : __logf(1.f + ex);
            sp *= -8.0f * 1.4426950408889634f;
        }
        { LAS float* dp = xr_s + t_ * 64 + c8;
          *(LAS f32x4*)dp = (f32x4){bf_lo(p0.x), bf_hi(p0.x), bf_lo(p0.y), bf_hi(p0.y)}; *(LAS f32x4*)(dp + 4) = (f32x4){bf_lo(p0.z), bf_hi(p0.z), bf_lo(p0.w), bf_hi(p0.w)};
          if (tid < 24) { LAS float* dq = xr_s + (64 + t_) * 64 + c8;
            *(LAS f32x4*)dq = (f32x4){bf_lo(p1.x), bf_hi(p1.x), bf_lo(p1.y), bf_hi(p1.y)}; *(LAS f32x4*)(dq + 4) = (f32x4){bf_lo(p1.z), bf_hi(p1.z), bf_lo(p1.w), bf_hi(p1.w)}; } }
        const u32x4 gv = pg;
        __syncthreads();
        const int Un = U + ustep;
        if (Un < uend) lru_prefetch(xg, Un, tid, p0, p1, pg);
        {
            float v[8];
#pragma unroll
            for (int e = 0; e < 8; ++e) v[e] = cbias[e];
#pragma unroll
            for (int k = 0; k < 4; ++k) { const f32x4 x0 = *(const LAS f32x4*)(xr_s + (t_ + k) * 64 + c8), x1 = *(const LAS f32x4*)(xr_s + (t_ + k) * 64 + c8 + 4);
#pragma unroll
                for (int e = 0; e < 4; ++e) { v[e] += cw[k][e] * x0[e]; v[4 + e] += cw[k][4 + e] * x1[e]; } }
            *(LAS f32x4*)(xcf + t_ * 64 + c8) = (f32x4){v[0], v[1], v[2], v[3]}; *(LAS f32x4*)(xcf + t_ * 64 + c8 + 4) = (f32x4){v[4], v[5], v[6], v[7]};
            u32x4 w; w.x = cvt_pk_bf16(v[0], v[1]); w.y = cvt_pk_bf16(v[2], v[3]); w.z = cvt_pk_bf16(v[4], v[5]); w.w = cvt_pk_bf16(v[6], v[7]);
            *(LAS u32x4*)(xcb + t_ * 72 + c8) = w;
        }
        __syncthreads();
        {
            bf16x8 Af[4][2];
#pragma unroll
            for (int m = 0; m < 4; ++m)
#pragma unroll
                for (int ks = 0; ks < 2; ++ks) Af[m][ks] = *(const LAS bf16x8*)(xcb + (16 * m + fr) * 72 + ks * 32 + fq * 8);
            f32x4 acc[2][4];
#pragma unroll
            for (int gt = 0; gt < 2; ++gt)
#pragma unroll
                for (int m = 0; m < 4; ++m) { acc[gt][m] = (f32x4){0.f, 0.f, 0.f, 0.f};
#pragma unroll
                    for (int ks = 0; ks < 2; ++ks) acc[gt][m] = __builtin_amdgcn_mfma_f32_16x16x32_bf16(Af[m][ks], Bf[gt][ks], acc[gt][m], 0, 0, 0); }
            float At, Ht;
            if (d == 0) lru_epi_scan<0>(acc, brg, big, sp, xcf, Hs, Ps, ch, fq, lane, At, Ht);
            else lru_epi_scan<1>(acc, brg, big, sp, xcf, Hs + 64 * 68, Ps + 64 * 68, ch, fq, lane, At, Ht);
            if (fq == 0) ((f32x2*)(ws + WS_LAGG))[((size_t)(b * LCH + cl) * 2 + d) * 512 + head * 64 + ch] = mk2(At, Ht);
        }
        __syncthreads();
        {
            const int tok = lru_tok(b, cl, t_);
            const float gr[8] = {bf_lo(gv.x), bf_hi(gv.x), bf_lo(gv.y), bf_hi(gv.y), bf_lo(gv.z), bf_hi(gv.z), bf_lo(gv.w), bf_hi(gv.w)};
            float yl[8], gf[8], gb[8];
            { const int o = t_ * 68 + c8;
              const f32x4 h00 = *(const LAS f32x4*)(Hs + o), h01 = *(const LAS f32x4*)(Hs + o + 4), h10 = *(const LAS f32x4*)(Hs + 64 * 68 + o), h11 = *(const LAS f32x4*)(Hs + 64 * 68 + o + 4);
              const f32x4 q00 = *(const LAS f32x4*)(Ps + o), q01 = *(const LAS f32x4*)(Ps + o + 4), q10 = *(const LAS f32x4*)(Ps + 64 * 68 + o), q11 = *(const LAS f32x4*)(Ps + 64 * 68 + o + 4);
#pragma unroll
              for (int e = 0; e < 4; ++e) { const float g0 = gelu_tanh(gr[e]), g1 = gelu_tanh(gr[4 + e]);
                yl[e] = (h00[e] + h10[e]) * g0; gf[e] = q00[e] * g0; gb[e] = q10[e] * g0;
                yl[4 + e] = (h01[e] + h11[e]) * g1; gf[4 + e] = q01[e] * g1; gb[4 + e] = q11[e] * g1; } }
            const size_t off = (size_t)tok * 512 + head * 64 + c8;
            u32x4 w; w.x = cvt_pk_bf16(yl[0], yl[1]); w.y = cvt_pk_bf16(yl[2], yl[3]); w.z = cvt_pk_bf16(yl[4], yl[5]); w.w = cvt_pk_bf16(yl[6], yl[7]);
            *(u32x4*)((bf16_t*)(ws + WS_YL) + off) = w;
            w.x = cvt_pk_bf16(gf[0], gf[1]); w.y = cvt_pk_bf16(gf[2], gf[3]); w.z = cvt_pk_bf16(gf[4], gf[5]); w.w = cvt_pk_bf16(gf[6], gf[7]);
            *(u32x4*)((bf16_t*)(ws + WS_GPF) + off) = w;
            w.x = cvt_pk_bf16(gb[0], gb[1]); w.y = cvt_pk_bf16(gb[2], gb[3]); w.z = cvt_pk_bf16(gb[4], gb[5]); w.w = cvt_pk_bf16(gb[6], gb[7]);
            *(u32x4*)((bf16_t*)(ws + WS_R2) + (size_t)tok * 1024 + head * 64 + c8) = w;
        }
        U = Un;
    }
    __syncthreads();
}
__device__ __forceinline__ void phase_lru_fin(unsigned char* ws) {
    const int tid = fresh_tid(), bid0 = fresh_bid();
    const float* lh = (const float*)(ws + WS_LHIN);
    const int nskip = gridDim.x >= 128 ? 64 : 0;
    if (bid0 < nskip) return;
    const int bid = bid0 - nskip, nb = (int)gridDim.x - nskip;
    for (int item = bid * 512 + tid; item < MTOK * 64; item += nb * 512) {
        const int tok = item >> 6, c8 = (item & 63) * 8, b = tok / POS, pos = tok % POS;
        const int cl = pos < CTXL ? (pos >> 6) : 4 + ((pos - CTXL) & 63);
        const size_t off = (size_t)tok * 512 + c8;
        const u32x4 yv = *(const u32x4*)((const bf16_t*)(ws + WS_YL) + off), fv = *(const u32x4*)((const bf16_t*)(ws + WS_GPF) + off), rv = *(const u32x4*)((const bf16_t*)(ws + WS_R2) + (size_t)tok * 1024 + c8);
        const float* hf = lh + ((size_t)(b * LCH + cl) * 2) * 512 + c8; const float* hr = hf + 512;
        const f32x4 f0 = *(const f32x4*)hf, f1 = *(const f32x4*)(hf + 4), r0 = *(const f32x4*)hr, r1 = *(const f32x4*)(hr + 4);
        u32x4 w;
        w.x = cvt_pk_bf16(bf_lo(yv.x) + bf_lo(fv.x) * f0[0] + bf_lo(rv.x) * r0[0], bf_hi(yv.x) + bf_hi(fv.x) * f0[1] + bf_hi(rv.x) * r0[1]);
        w.y = cvt_pk_bf16(bf_lo(yv.y) + bf_lo(fv.y) * f0[2] + bf_lo(rv.y) * r0[2], bf_hi(yv.y) + bf_hi(fv.y) * f0[3] + bf_hi(rv.y) * r0[3]);
        w.z = cvt_pk_bf16(bf_lo(yv.z) + bf_lo(fv.z) * f1[0] + bf_lo(rv.z) * r1[0], bf_hi(yv.z) + bf_hi(fv.z) * f1[1] + bf_hi(rv.z) * r1[1]);
        w.w = cvt_pk_bf16(bf_lo(yv.w) + bf_lo(fv.w) * f1[2] + bf_lo(rv.w) * r1[2], bf_hi(yv.w) + bf_hi(fv.w) * f1[3] + bf_hi(rv.w) * r1[3]);
        *(u32x4*)((bf16_t*)(ws + WS_R2) + (size_t)tok * 1024 + 512 + c8) = w;
    }
}

__device__ __forceinline__ void phase_carry(unsigned char* ws) {
    const int tid = fresh_tid(), bid = fresh_bid();
    const int lane = tid & 63, wid = tid >> 6;
    for (int item = wid * gridDim.x + bid; item < 640; item += 8 * gridDim.x) {
        if (item < 512) {
            const int g = item >> 4, b = (item >> 1) & 7, d = item & 1, n = lane;
            const f32x2 aT = ((const f32x2*)(ws + WS_AT))[(g * 2 + d) * 64 + n];
            const f32x2* hl = (const f32x2*)(ws + WS_HLOC) + ((size_t)(g * MS + b * SCH) * 256 + d * 128 + 2 * n) / 2;
            unsigned* hin = (unsigned*)(ws + WS_US5) + ((size_t)(g * MSP + b * SCH) * K3 + 512 + d * 128 + 2 * n) / 2;
            float hr = 0.f, hi = 0.f;
            for (int ib = 0; ib < SCH / 8; ++ib) {
                f32x2 L[8];
#pragma unroll
                for (int e = 0; e < 8; ++e) { const int i = ib * 8 + e, c = d == 0 ? i : (i < 8 ? 7 - i : 143 - i); L[e] = hl[(size_t)c * 128]; }
#pragma unroll
                for (int e = 0; e < 8; ++e) { const int i = ib * 8 + e, c = d == 0 ? i : (i < 8 ? 7 - i : 143 - i);
                    hin[(size_t)c * (K3 / 2)] = cvt_pk_bf16(hr, hi);
                    const float nr = aT.x * hr - aT.y * hi + L[e].x, ni = aT.x * hi + aT.y * hr + L[e].y; hr = nr; hi = ni; }
            }
        } else {
            const int tl = (item - 512) * 64 + lane, b = tl >> 10, d = (tl >> 9) & 1, ch = tl & 511;
            const f32x2* ag = (const f32x2*)(ws + WS_LAGG) + ((size_t)b * LCH * 2 + d) * 512 + ch;
            float* hin = (float*)(ws + WS_LHIN) + ((size_t)b * LCH * 2 + d) * 512 + ch;
            float H = 0.f;
            for (int ib = 0; ib < LCH / 4; ++ib) {
                f32x2 L[4];
#pragma unroll
                for (int e = 0; e < 4; ++e) { const int i = ib * 4 + e, cl = d == 0 ? i : (i < 4 ? 3 - i : 71 - i); L[e] = ag[(size_t)cl * 1024]; }
#pragma unroll
                for (int e = 0; e < 4; ++e) { const int i = ib * 4 + e, cl = d == 0 ? i : (i < 4 ? 3 - i : 71 - i); hin[(size_t)cl * 1024] = H; H = L[e].x * H + L[e].y; }
            }
        }
    }
}

#define XB_TMO      128
#define XB_XCNT(j)  (256  + 64 * (j))
#define XB_XSUB(j)  (1280 + 64 * (j))
#define XB_XGEN(j)  (2304 + 64 * (j))
#define XB_TOP      3328
#define XB_TOPGEN   3392
#define XCD_BAR_WORDS 3456
#define XB_SPIN_CAP (1u << 22)
__device__ __forceinline__ unsigned xb_ld(unsigned* p)              { return __hip_atomic_load(p, __ATOMIC_RELAXED, __HIP_MEMORY_SCOPE_AGENT); }
__device__ __forceinline__ unsigned xb_add(unsigned* p, unsigned v) { return __hip_atomic_fetch_add(p, v, __ATOMIC_RELAXED, __HIP_MEMORY_SCOPE_AGENT); }
__device__ __forceinline__ unsigned xb_xcc_id() { return (unsigned)__builtin_amdgcn_s_getreg((3 << 11) | 20) & 0xFu; }
#define XB_SPIN(cond, bar) do { unsigned _sp = 0; while (cond) { __builtin_amdgcn_s_sleep(1); \
    if ((++_sp & 255u) == 0u) { if (xb_ld(&(bar)[XB_TMO])) break; if (_sp > XB_SPIN_CAP) { atomicAdd(&(bar)[XB_TMO], 1u); break; } } } } while (0)
__device__ __forceinline__ void xcd_barrier_complete(unsigned* bar, unsigned x, unsigned& nloc, unsigned& nx) {
    const unsigned G = gridDim.x * gridDim.y * gridDim.z;
    unsigned sum, cnt, mine, sp = 0u;
    for (;;) {
        sum = 0u; cnt = 0u; mine = 0u;
#pragma unroll
        for (unsigned j = 0; j < 16; ++j) { const unsigned c = xb_ld(&bar[XB_XCNT(j)]); sum += c; cnt += (c > 0u) ? 1u : 0u; mine = (j == x) ? c : mine; }
        if (sum == G) break;
        __builtin_amdgcn_s_sleep(1);
        if ((++sp & 255u) == 0u) { if (xb_ld(&bar[XB_TMO])) break; if (sp > XB_SPIN_CAP) { atomicAdd(&bar[XB_TMO], 1u); break; } }
    }
    nloc = mine > 0u ? mine : 1u; nx = cnt > 0u ? cnt : 1u;
}
__device__ __forceinline__ void xcd_barrier(unsigned* bar, volatile LAS unsigned* st) {
    asm volatile("s_waitcnt vmcnt(0)" ::: "memory");
    __syncthreads();
    if (threadIdx.x == 0) {
        const unsigned x = xb_xcc_id();
        __builtin_amdgcn_s_waitcnt(0);
        unsigned nloc = st[0], nx = st[1];
        if (nloc == 0u) { xcd_barrier_complete(bar, x, nloc, nx); st[0] = nloc; st[1] = nx; }
        const unsigned old = xb_add(&bar[XB_XSUB(x)], 1u);
        const unsigned gen = old / nloc;
        if (old + 1u == (gen + 1u) * nloc) {
            __builtin_amdgcn_fence(__ATOMIC_RELEASE, "agent");
            asm volatile("s_waitcnt vmcnt(0)" ::: "memory");
            const unsigned og = xb_add(&bar[XB_TOP], 1u);
            const unsigned tg = og / nx;
            if (og + 1u == (tg + 1u) * nx) xb_add(&bar[XB_TOPGEN], 1u);
            else XB_SPIN(xb_ld(&bar[XB_TOPGEN]) == tg, bar);
            __builtin_amdgcn_fence(__ATOMIC_ACQUIRE, "agent");
            xb_add(&bar[XB_XGEN(x)], 1u);
            asm volatile("s_waitcnt vmcnt(0)" ::: "memory");
        } else {
            XB_SPIN(xb_ld(&bar[XB_XGEN(x)]) == gen, bar);
            __builtin_amdgcn_fence(__ATOMIC_ACQUIRE, "agent");
            asm volatile("s_waitcnt vmcnt(0)" ::: "memory");
        }
    }
    __syncthreads();
}

__global__ void __launch_bounds__(512, 2) mega(Args a_unused) {
    extern __shared__ __attribute__((aligned(16))) unsigned char lds_raw[];
    LAS unsigned char* lds = (LAS unsigned char*)lds_raw;
    cg::grid_group grid = cg::this_grid();
    const int G = gridDim.x, c = blockIdx.x;
    volatile LAS unsigned* bst = (volatile LAS unsigned*)(lds + (LDS_BYTES - 16));
    unsigned* const gbar = (unsigned*)(kargs()->ws + WS_BAR);
    if (threadIdx.x == 0) { bst[0] = 0u; bst[1] = 0u; (void)xb_add(&gbar[XB_XCNT(xb_xcc_id())], 1u); }
    __syncthreads();
#define GSYNC() do { xcd_barrier(gbar, bst); if (PROBE_ID == 15) { xcd_barrier(gbar, bst); xcd_barrier(gbar, bst); } } while (0)
#define PH_BEGIN KArgP a = kargs(); unsigned char* ws = fresh_ws(); (void)a; (void)ws;

    if (G >= 64) {
        if (c < 32) { PH_BEGIN s5tab_group(a, ws, lds, 0, c); }
        else { { PH_BEGIN phase_mod(a, ws, lds, c - 32, G - 32); } { PH_BEGIN phase_wconv(a, ws, lds, 0, c - 32, G - 32); } }
    } else {
        { PH_BEGIN for (int g = c; g < NG; g += G) s5tab_group(a, ws, lds, 0, g); }
        { PH_BEGIN phase_mod(a, ws, lds, c, G); }
        { PH_BEGIN phase_wconv(a, ws, lds, 0, c, G); }
    }
    grid.sync();
#if PM & 8
    { PH_BEGIN PB(2) phase_norm<0>(a, ws, 0); PE(2) }
#endif
    GSYNC();

#pragma unroll 1
    for (int l = 0; l < DEPTH; ++l) {
#if PM & 16
        for (int rep = 0; rep < REP_GEMM; ++rep) { PH_BEGIN PB(5) unsigned char* wl = ws + WS_WL + (size_t)(l & 1) * WL_SIZE;
          PlainOrder S; S.init(ws + WS_R2, 1024, wl + WL_IN, 1024, MTOK, DIN, G, c); EpiIn E{(bf16_t*)(ws + WS_US5), (bf16_t*)(ws + WS_XG)};
          gemm_phase<EpiIn, PlainOrder>(lds, 1024, 1024, 1024, S, E); PE(5) }
#endif
        GSYNC();
#if PM & 32
        for (int rep = 0; rep < REP_GEMM; ++rep) { PH_BEGIN PB(6) BatchOrder S; S.init(ws + WS_US5, K3, (size_t)MSP * K3 * 2, ws + WS_BT1, K1, (size_t)256 * K1 * 2, MSP / BM, 1, NG, G, c); EpiHloc E{(float*)(ws + WS_HLOC)};
          gemm_phase<EpiHloc, BatchOrder>(lds, K3, K1, K1, S, E); PE(6) }
#endif
#if PM & 2048
        for (int rep = 0; rep < REP_LRU; ++rep) { PH_BEGIN PB(3) phase_lru(a, ws, lds, l); PE(3) }
#endif
        GSYNC();
#if PM & 8192
        for (int rep = 0; rep < REP_CARRY; ++rep) { PH_BEGIN PB(13) phase_carry(ws); PE(13) }
#endif
        GSYNC();
#if PM & 64
        for (int rep = 0; rep < REP_GEMM; ++rep) { PH_BEGIN PB(7) BatchOrder S; S.init(ws + WS_US5, K3, (size_t)MSP * K3 * 2, ws + WS_BT3, K3, (size_t)512 * K3 * 2, MSP / BM, 2, NG, G, c); EpiY1 E{(bf16_t*)(ws + WS_Y1)};
          gemm_phase<EpiY1, BatchOrder>(lds, K3, K3, K3, S, E); PE(7) }
#endif
#if PM & 4096
        for (int rep = 0; rep < REP_LRU; ++rep) { PH_BEGIN PB(4) phase_lru_fin(ws); PE(4) }
#endif
        GSYNC();
#if PM & 128
        for (int rep = 0; rep < REP_GEMM; ++rep) { PH_BEGIN PB(8) unsigned char* wl = ws + WS_WL + (size_t)(l & 1) * WL_SIZE;
          PlainOrder S; S.init(ws + WS_Y1, 512, wl + WL_GLU, 512, MTOK, 512, G, c, l == DEPTH - 1); EpiGlu E{(const bf16_t*)(ws + WS_Y1), (bf16_t*)(ws + WS_R2), a->in[17] + l * 512};
          gemm_phase<EpiGlu, PlainOrder>(lds, 512, 512, 512, S, E); PE(8) }
#endif
        GSYNC();
        { PH_BEGIN PB(9) unsigned char* wl = ws + WS_WL + (size_t)(l & 1) * WL_SIZE; unsigned* ctr = (unsigned*)(ws + WS_CTR) + (l * 2 + 0) * 256;
          PanelOrder S; S.init(ws + WS_R2, 1024, wl + WL_OUT, 1024, G, c, l == DEPTH - 1); EpiOutPub E{(bf16_t*)(ws + WS_R3), (float*)(ws + WS_ROWSS), ctr};
          gemm_phase<EpiOutPub, PanelOrder>(lds, 1024, 1024, 1024, S, E); PE(9) }
        { PH_BEGIN PB(2) unsigned* ctr = (unsigned*)(ws + WS_CTR) + (l * 2 + 0) * 256; norm_tasks<1>(a, ws, lds, l, ctr, l == DEPTH - 1); PE(2) }
        GSYNC();
#if PM & 512
        for (int rep = 0; rep < REP_GEMM; ++rep) { PH_BEGIN PB(10) unsigned char* wl = ws + WS_WL + (size_t)(l & 1) * WL_SIZE;
          PlainOrder S; S.init(ws + WS_R2, 1024, wl + WL_FI, 1024, MTOK, 2 * DFF, G, c, l == DEPTH - 1); EpiFfn E{(bf16_t*)(ws + WS_AFF)};
          gemm_phase<EpiFfn, PlainOrder>(lds, 1024, 1024, 1024, S, E); PE(10) }
#endif
        GSYNC();
        { PH_BEGIN PB(11) unsigned char* wl = ws + WS_WL + (size_t)(l & 1) * WL_SIZE; unsigned* ctr = (unsigned*)(ws + WS_CTR) + (l * 2 + 1) * 256;
          PanelOrder S; S.init(ws + WS_AFF, DFF, wl + WL_FO, DFF, G, c, l == DEPTH - 1); EpiOutPub E{(bf16_t*)(ws + WS_R3), (float*)(ws + WS_ROWSS), ctr};
          gemm_phase<EpiOutPub, PanelOrder>(lds, DFF, DFF, DFF, S, E); PE(11) }
        if (l + 1 < DEPTH) { PH_BEGIN PB(14)
            if (G >= 128) { if (c >= 32 && c < 64) s5tab_group(a, ws, lds, l + 1, c - 32); else if (c >= 64) phase_wconv(a, ws, lds, l + 1, c - 64, G - 64); }
            else { for (int g = c; g < NG; g += G) s5tab_group(a, ws, lds, l + 1, g); phase_wconv(a, ws, lds, l + 1, c, G); }
            PE(14) }
        { PH_BEGIN PB(2) unsigned* ctr = (unsigned*)(ws + WS_CTR) + (l * 2 + 1) * 256; norm_tasks<2>(a, ws, lds, l, ctr, l == DEPTH - 1); PE(2) }
        if (l + 1 < DEPTH) GSYNC();
    }
}

extern "C" void kernel_launch(void* const* d_in, const int* in_sizes, int n_in, void* d_out, int out_size, void* d_ws, size_t ws_size, hipStream_t stream) {
    static int grid = 0;
    if (grid == 0) {
        if (n_in != 28 || out_size != NB * SEQ * D || ws_size < WS_END) { fprintf(stderr, "kernel_launch: unexpected shapes (n_in %d, out %d, ws %zu, need %zu)\n", n_in, out_size, ws_size, (size_t)WS_END); grid = -1; return; }
        int dev = 0, cus = 0, per_cu = 0;
        hipGetDevice(&dev); hipDeviceGetAttribute(&cus, hipDeviceAttributeMultiprocessorCount, dev);
        if (hipFuncSetAttribute((const void*)mega, hipFuncAttributeMaxDynamicSharedMemorySize, LDS_BYTES) != hipSuccess) { fprintf(stderr, "kernel_launch: hipFuncSetAttribute failed\n"); grid = -1; return; }
        if (hipOccupancyMaxActiveBlocksPerMultiprocessor(&per_cu, (const void*)mega, 512, LDS_BYTES) != hipSuccess || per_cu < 1) { fprintf(stderr, "kernel_launch: occupancy query says %d\n", per_cu); per_cu = 1; }
        (void)hipGetLastError();
        grid = cus * 1;
        if (grid <= 0) grid = 256;
    }
    if (grid < 0) return;
    if (hipMemsetAsync((char*)d_ws + WS_BAR, 0, 16384 + 8192, stream) != hipSuccess) { fprintf(stderr, "kernel_launch: memset failed\n"); return; }
    Args a{};
    for (int i = 0; i < 28; ++i) a.in[i] = (const float*)d_in[i];
    a.out = (float*)d_out; a.ws = (unsigned char*)d_ws;
    void* args[] = {&a};
    hipError_t e = hipLaunchCooperativeKernel((const void*)mega, dim3(grid), dim3(512), args, LDS_BYTES, stream);
    if (e != hipSuccess) fprintf(stderr, "kernel_launch: cooperative launch failed: %s (grid %d)\n", hipGetErrorString(e), grid);
}
```
